# Optimizing an MI355X kernel written in HIP

```python
import jax, jax.numpy as jnp
from jax import lax
import numpy as np

D_MODEL = 1024
BATCH = 2
SEQ = 8192
DEPTH = 1

N_META = 16
D_MIX = D_MODEL
LRU_WIDTH = D_MIX // 2
LRU_HEADS = 8
LRU_HEAD_DIM = LRU_WIDTH // LRU_HEADS
RG_LRU_C = 8.0
CONV_WIDTH = 4
CONV_LEFT = 2
FOURIER_WIDTH = D_MIX - LRU_WIDTH
FOURIER_GROUPS = 8
FOURIER_GROUP_DIM = FOURIER_WIDTH // FOURIER_GROUPS
D_IN_PROJ = 2 * LRU_WIDTH + FOURIER_WIDTH
D_FF = 2816
EPS = 1e-6

kernel_name = "hybrid_rglru_fnet_macaron_encoder"


def rms_norm(x, g):
    xf = x.astype(jnp.float32)
    y = xf * lax.rsqrt(jnp.mean(xf * xf, axis=-1, keepdims=True) + EPS)
    return (y * g.astype(jnp.float32)).astype(x.dtype)


def swiglu(h, w_in, w_out):
    gate, up = jnp.split(h @ w_in, 2, axis=-1)
    return (jax.nn.silu(gate) * up) @ w_out


def centred_depthwise_conv(x, w, b):
    T = x.shape[1]
    xp = jnp.pad(x, ((0, 0), (CONV_LEFT, CONV_WIDTH - 1 - CONV_LEFT), (0, 0)))
    out = xp[:, 0:T] * w[0]
    for k in range(1, CONV_WIDTH):
        out = out + xp[:, k:k + T] * w[k]
    return out + b


def linear_recurrence(a, b):
    def combine(l, r):
        return (l[0] * r[0], r[0] * l[1] + r[1])
    _, h = lax.associative_scan(combine, (a, b), axis=1)
    return h


def block_diag(x, w, b):
    B, T, _ = x.shape
    H, Dh, _ = w.shape
    y = jnp.einsum('bthi,hij->bthj', x.reshape(B, T, H, Dh), w)
    return y.reshape(B, T, H * Dh) + b


def rg_lru(xc, wa, ba, wx, bx, lam):
    r = jax.nn.sigmoid(block_diag(xc, wa, ba))
    i = jax.nn.sigmoid(block_diag(xc, wx, bx))
    log_a = -RG_LRU_C * r * jax.nn.softplus(-lam)
    a = jnp.exp(log_a)
    mult = jnp.sqrt(-jnp.expm1(2.0 * log_a))
    return linear_recurrence(a, mult * (i * xc))


def fourier_mix(v, w, b):
    B, T, _ = v.shape
    vg = v.astype(jnp.float32).reshape(B, T, FOURIER_GROUPS, FOURIER_GROUP_DIM)
    f = jnp.fft.fft2(vg, axes=(1, 3), norm='ortho').real
    y = jnp.einsum('btgi,gij->btgj', f, w.astype(jnp.float32))
    return y.reshape(B, T, FOURIER_WIDTH) + b.astype(jnp.float32)


def setup_inputs(seed: int = 0) -> dict:
    key = jax.random.key(seed)
    ks = jax.random.split(key, 32)
    nrm = lambda k, shape, scale: jax.random.normal(k, shape, jnp.float32) * scale
    gain = lambda k, shape: 1.0 + 0.02 * jax.random.normal(k, shape, jnp.float32)

    def lru_lambda(k):
        ac = jax.random.uniform(k, (DEPTH, LRU_WIDTH), jnp.float32, 0.9, 0.999)
        a = ac ** (1.0 / RG_LRU_C)
        return jnp.log(a) - jnp.log1p(-a)

    hd = LRU_HEAD_DIM ** -0.5
    return {
        "x": nrm(ks[0], (BATCH, SEQ, D_MODEL), 1.0),
        "meta_tokens": nrm(ks[1], (N_META, D_MODEL), 1.0),
        "norm_ffn1": gain(ks[2], (DEPTH, D_MODEL)),
        "w_ffn1_in": nrm(ks[3], (DEPTH, D_MODEL, 2 * D_FF), D_MODEL ** -0.5),
        "w_ffn1_out": nrm(ks[4], (DEPTH, D_FF, D_MODEL), D_FF ** -0.5),
        "norm_mix": gain(ks[5], (DEPTH, D_MODEL)),
        "w_in": nrm(ks[6], (DEPTH, D_MODEL, D_IN_PROJ), D_MODEL ** -0.5),
        "conv_w": nrm(ks[7], (DEPTH, CONV_WIDTH, LRU_WIDTH), CONV_WIDTH ** -0.5),
        "conv_b": nrm(ks[8], (DEPTH, LRU_WIDTH), 0.02),
        "lru_wa_fwd": nrm(ks[9], (DEPTH, LRU_HEADS, LRU_HEAD_DIM, LRU_HEAD_DIM), hd),
        "lru_ba_fwd": nrm(ks[10], (DEPTH, LRU_WIDTH), 0.02),
        "lru_wx_fwd": nrm(ks[11], (DEPTH, LRU_HEADS, LRU_HEAD_DIM, LRU_HEAD_DIM), hd),
        "lru_bx_fwd": nrm(ks[12], (DEPTH, LRU_WIDTH), 0.02),
        "lru_lambda_fwd": lru_lambda(ks[13]),
        "lru_wa_bwd": nrm(ks[14], (DEPTH, LRU_HEADS, LRU_HEAD_DIM, LRU_HEAD_DIM), hd),
        "lru_ba_bwd": nrm(ks[15], (DEPTH, LRU_WIDTH), 0.02),
        "lru_wx_bwd": nrm(ks[16], (DEPTH, LRU_HEADS, LRU_HEAD_DIM, LRU_HEAD_DIM), hd),
        "lru_bx_bwd": nrm(ks[17], (DEPTH, LRU_WIDTH), 0.02),
        "lru_lambda_bwd": lru_lambda(ks[18]),
        "fourier_w": nrm(ks[19], (DEPTH, FOURIER_GROUPS, FOURIER_GROUP_DIM, FOURIER_GROUP_DIM), FOURIER_GROUP_DIM ** -0.5),
        "fourier_b": nrm(ks[20], (DEPTH, FOURIER_WIDTH), 0.02),
        "norm_lru_out": gain(ks[21], (DEPTH, LRU_WIDTH)),
        "norm_fourier_out": gain(ks[22], (DEPTH, FOURIER_WIDTH)),
        "w_out": nrm(ks[23], (DEPTH, D_MIX, D_MODEL), D_MIX ** -0.5),
        "norm_ffn2": gain(ks[24], (DEPTH, D_MODEL)),
        "w_ffn2_in": nrm(ks[25], (DEPTH, D_MODEL, 2 * D_FF), D_MODEL ** -0.5),
        "w_ffn2_out": nrm(ks[26], (DEPTH, D_FF, D_MODEL), D_FF ** -0.5),
        "norm_final": gain(ks[27], (D_MODEL,)),
    }


def reference(x, meta_tokens, norm_ffn1, w_ffn1_in, w_ffn1_out, norm_mix, w_in, conv_w, conv_b,
              lru_wa_fwd, lru_ba_fwd, lru_wx_fwd, lru_bx_fwd, lru_lambda_fwd,
              lru_wa_bwd, lru_ba_bwd, lru_wx_bwd, lru_bx_bwd, lru_lambda_bwd,
              fourier_w, fourier_b, norm_lru_out, norm_fourier_out, w_out,
              norm_ffn2, w_ffn2_in, w_ffn2_out, norm_final):
    B = x.shape[0]
    meta = jnp.broadcast_to(meta_tokens.astype(x.dtype)[None], (B, N_META, D_MODEL))
    h = jnp.concatenate([meta, x], axis=1)

    for l in range(DEPTH):
        h = h + 0.5 * swiglu(rms_norm(h, norm_ffn1[l]), w_ffn1_in[l], w_ffn1_out[l])

        u = rms_norm(h, norm_mix[l]) @ w_in[l]
        lru_x = u[..., :LRU_WIDTH]
        lru_gate = u[..., LRU_WIDTH:2 * LRU_WIDTH]
        four_v = u[..., 2 * LRU_WIDTH:]

        xc = centred_depthwise_conv(lru_x, conv_w[l], conv_b[l]).astype(jnp.float32)
        h_fwd = rg_lru(xc, lru_wa_fwd[l].astype(jnp.float32), lru_ba_fwd[l].astype(jnp.float32),
                       lru_wx_fwd[l].astype(jnp.float32), lru_bx_fwd[l].astype(jnp.float32),
                       lru_lambda_fwd[l].astype(jnp.float32))
        h_bwd = jnp.flip(rg_lru(jnp.flip(xc, axis=1), lru_wa_bwd[l].astype(jnp.float32),
                                lru_ba_bwd[l].astype(jnp.float32), lru_wx_bwd[l].astype(jnp.float32),
                                lru_bx_bwd[l].astype(jnp.float32), lru_lambda_bwd[l].astype(jnp.float32)), axis=1)
        y_lru = (h_fwd + h_bwd) * jax.nn.gelu(lru_gate.astype(jnp.float32))
        y_lru = rms_norm(y_lru, norm_lru_out[l]).astype(h.dtype)

        y_four = rms_norm(fourier_mix(four_v, fourier_w[l], fourier_b[l]), norm_fourier_out[l]).astype(h.dtype)

        h = h + jnp.concatenate([y_lru, y_four], axis=-1) @ w_out[l]

        h = h + 0.5 * swiglu(rms_norm(h, norm_ffn2[l]), w_ffn2_in[l], w_ffn2_out[l])

    return rms_norm(h, norm_final)[:, N_META:]
```

```cpp
#include <hip/hip_runtime.h>
#include <cstdio>
#include <cstdint>
#include <cmath>
namespace pg8 {
#define PG8_LAS __attribute__((address_space(3)))
typedef unsigned short bf16_t;
typedef short bf16x8 __attribute__((ext_vector_type(8)));
typedef float f32x4 __attribute__((ext_vector_type(4)));
typedef unsigned u32x4 __attribute__((ext_vector_type(4)));
constexpr int BM = 256, BK = 64, HALF = 128, HTB = HALF * BK * 2  , STAGE_BYTES = 8 * HTB, NXCD = 8, WGM = 8;

__host__ __device__ __forceinline__ int lds_byte(int r, int c) { const int st = (r >> 4) * 2 + (c >> 5), rr = r & 15, cc = c & 31, ob = rr * 64 + cc * 2; return st * 1024 + (ob ^ (((ob >> 9) & 1) << 5)); }
__host__ __device__ __forceinline__ void stage_rc(int b, int& R, int& C) { const int st = b / 1024, sb = b % 1024, swz = sb ^ (((sb >> 9) & 1) << 5); R = (st >> 1) * 16 + swz / 64; C = (st & 1) * 32 + (swz % 64) / 2; }
__host__ __device__ __forceinline__ int perm32(int rho) { const int n = rho >> 4, i = rho & 15; return 8 * (i >> 2) + 4 * n + (i & 3); }

struct Unit { int pm, pn; };
struct Gemm { const bf16_t* A; const bf16_t* Bt; int M, N, K; };

struct StaticOrder {
    int nM, nN, nwg, G, c;
    __host__ __device__ void init(int M, int N, int G_, int c_) { nM = M / BM; nN = N / BM; nwg = nM * nN; G = G_; c = c_; }
    __host__ __device__ bool next(int i, Unit& u) const {
        const long L = (long)i * G + c; if (L >= nwg) return false;
        int wgid = (int)L; { const int q = nwg / NXCD, r = nwg % NXCD, xcd = wgid % NXCD, off = wgid / NXCD; wgid = (xcd < r ? xcd * (q + 1) : r * (q + 1) + (xcd - r) * q) + off; }
        const int nig = WGM * nN, gid = wgid / nig, fm = gid * WGM, gsz = (nM - fm) < WGM ? (nM - fm) : WGM;
        u.pm = fm + ((wgid % nig) % gsz); u.pn = (wgid % nig) / gsz; return true;
    }
    __device__ __forceinline__ void a_ready(const Unit&) const {}
    __device__ __forceinline__ void done(const Unit&) const {}
};

__device__ __forceinline__ unsigned cvt_pk_bf16(float lo, float hi) { unsigned r; asm volatile("v_cvt_pk_bf16_f32 %0, %1, %2" : "=v"(r) : "v"(lo), "v"(hi)); return r; }
typedef unsigned u32x2 __attribute__((ext_vector_type(2)));
constexpr float RMS_EPS = 1e-6f;
__device__ __forceinline__ float row_rstd(const float* slots, int r) {
    const f32x4* p = (const f32x4*)(slots + (size_t)r * 16);
    const f32x4 a = p[0], b = p[1], c = p[2], d = p[3];
    const float s = (((a[0] + a[1]) + (a[2] + a[3])) + ((b[0] + b[1]) + (b[2] + b[3]))) + (((c[0] + c[1]) + (c[2] + c[3])) + ((d[0] + d[1]) + (d[2] + d[3])));
    return 1.0f / sqrtf(s * (1.0f / 1024.0f) + RMS_EPS);
}
__device__ __forceinline__ float silu_mul(float g, float u) {
    const float e = __builtin_amdgcn_exp2f(g * -1.44269504089f);
    return g * __builtin_amdgcn_rcpf(1.0f + e) * u;
}
struct EpiSwiglu {
    static constexpr bool PERM = true, AFTER_DRAIN = false;
    bf16_t* O; int ldc; const float* slots;
    __device__ __forceinline__ void operator()(const f32x4 (&acc)[2][2][4][2], const Unit& u, int wr, int wc, int fr, int fq) const {
        const int row0 = u.pm * BM + wr * 64 + fr, col0 = u.pn * HALF + wc * 32 + 8 * fq;
#pragma unroll
        for (int ai = 0; ai < 2; ++ai)
#pragma unroll
            for (int m = 0; m < 4; ++m) { const int r = row0 + ai * HALF + m * 16; const float s = slots ? row_rstd(slots, r) : 1.0f;
                const f32x4 g0 = acc[ai][0][m][0] * s, g1 = acc[ai][0][m][1] * s, u0 = acc[ai][1][m][0] * s, u1 = acc[ai][1][m][1] * s;
                u32x4 w; w.x = cvt_pk_bf16(silu_mul(g0[0], u0[0]), silu_mul(g0[1], u0[1])); w.y = cvt_pk_bf16(silu_mul(g0[2], u0[2]), silu_mul(g0[3], u0[3]));
                w.z = cvt_pk_bf16(silu_mul(g1[0], u1[0]), silu_mul(g1[1], u1[1])); w.w = cvt_pk_bf16(silu_mul(g1[2], u1[2]), silu_mul(g1[3], u1[3]));
                *(u32x4*)(O + (size_t)r * ldc + col0) = w; }
    }
};
struct EpiScaleBf16 {
    static constexpr bool PERM = true, AFTER_DRAIN = false;
    bf16_t* O; int ldc; const float* slots;
    __device__ __forceinline__ void operator()(const f32x4 (&acc)[2][2][4][2], const Unit& u, int wr, int wc, int fr, int fq) const {
        const int row0 = u.pm * BM + wr * 64 + fr, col0 = u.pn * BM + wc * 32 + 8 * fq;
#pragma unroll
        for (int ai = 0; ai < 2; ++ai)
#pragma unroll
            for (int m = 0; m < 4; ++m) { const int r = row0 + ai * HALF + m * 16; const float s = row_rstd(slots, r); bf16_t* rowp = O + (size_t)r * ldc + col0;
#pragma unroll
                for (int bj = 0; bj < 2; ++bj) { const f32x4 v0 = acc[ai][bj][m][0] * s, v1 = acc[ai][bj][m][1] * s;
                    u32x4 w; w.x = cvt_pk_bf16(v0[0], v0[1]); w.y = cvt_pk_bf16(v0[2], v0[3]); w.z = cvt_pk_bf16(v1[0], v1[1]); w.w = cvt_pk_bf16(v1[2], v1[3]);
                    *(u32x4*)(rowp + bj * HALF) = w; } }
    }
};
struct EpiResid {
    static constexpr bool PERM = false, AFTER_DRAIN = false;
    const float* base; float* out; bf16_t* ob; float* slots; float alpha; int ldc;
    __device__ __forceinline__ void operator()(const f32x4 (&acc)[2][2][4][2], const Unit& u, int wr, int wc, int fr, int fq) const {
        const int row0 = u.pm * BM + wr * 64 + fr, col0 = u.pn * BM + wc * 32 + 4 * fq;
#pragma unroll
        for (int ai = 0; ai < 2; ++ai)
#pragma unroll
            for (int m = 0; m < 4; ++m) { const int r = row0 + ai * HALF + m * 16; const size_t off = (size_t)r * ldc + col0; float ss = 0.f;
#pragma unroll
                for (int bj = 0; bj < 2; ++bj)
#pragma unroll
                    for (int n = 0; n < 2; ++n) { const size_t o = off + bj * HALF + n * 16; const f32x4 b = *(const f32x4*)(base + o); const f32x4 v = b + acc[ai][bj][m][n] * alpha;
                        *(f32x4*)(out + o) = v; ss += (v[0] * v[0] + v[1] * v[1]) + (v[2] * v[2] + v[3] * v[3]);
                        if (ob) { u32x2 w; w.x = cvt_pk_bf16(v[0], v[1]); w.y = cvt_pk_bf16(v[2], v[3]); *(u32x2*)(ob + o) = w; } }
                ss += __shfl_xor(ss, 16); ss += __shfl_xor(ss, 32);
                if (fq == 0) slots[(size_t)r * 16 + u.pn * 4 + wc] = ss; }
    }
};

template <class Epi, class Sched, bool ALIGN_EPI = false, bool SP2 = false>
__device__ __forceinline__ void gemm_phase(PG8_LAS unsigned char* lds, const Gemm g, const Sched& S, const Epi& E) {
    const int tid = threadIdx.x, wid = __builtin_amdgcn_readfirstlane(tid >> 6), lane = tid & 63, wr = wid >> 2, wc = wid & 3, fr = lane & 15, fq = lane >> 4;
    const int K = g.K, nt = K / BK;
    unsigned voffA[2], voffB[2];
#pragma unroll
    for (int i = 0; i < 2; ++i) { int R, C; stage_rc(tid * 16 + i * 8192, R, C); const int Rb = Epi::PERM ? ((R & ~31) + perm32(R & 31)) : R;
        voffA[i] = (unsigned)(R * K + C) * 2u; voffB[i] = (unsigned)(Rb * K + C) * 2u; }
    const size_t kstep = (size_t)(BK * 2);
    const size_t hstep = (size_t)HALF * K * 2;
    const size_t tstep = 2 * hstep;
    const unsigned ldsw = (unsigned)wid * 1024u;
    const int aoff = lds_byte(wr * 64 + fr, fq * 8), boff = lds_byte(wc * 32 + fr, fq * 8);
#define PG8_SA(b, h) (((b) * 2 + (h)) * HTB)
#define PG8_SB(b, h) ((4 + (b) * 2 + (h)) * HTB)
#define PG8_STAGE(bufoff, gbase, voff) do { _Pragma("unroll") for (int _i = 0; _i < 2; ++_i) \
        __builtin_amdgcn_global_load_lds((const unsigned*)((const char*)(gbase) + (voff)[_i]), (PG8_LAS unsigned*)(lds + (bufoff) + ldsw + _i * 8192), 16, 0, 0); } while (0)
#define PG8_LDA(dst, b, h) do { _Pragma("unroll") for (int m = 0; m < 4; ++m) _Pragma("unroll") for (int k = 0; k < 2; ++k) dst[m][k] = *(const PG8_LAS bf16x8*)(lds + PG8_SA(b, h) + aoff + m * 2048 + k * 1024); } while (0)
#define PG8_LDB(dst, b, h) do { _Pragma("unroll") for (int n = 0; n < 2; ++n) _Pragma("unroll") for (int k = 0; k < 2; ++k) dst[n][k] = *(const PG8_LAS bf16x8*)(lds + PG8_SB(b, h) + boff + n * 2048 + k * 1024); } while (0)
#define PG8_MMA(ai, bj, At, Bt) do { __builtin_amdgcn_s_setprio(1); _Pragma("unroll") for (int m = 0; m < 4; ++m) _Pragma("unroll") for (int n = 0; n < 2; ++n) _Pragma("unroll") for (int k = 0; k < 2; ++k) \
        acc[ai][bj][m][n] = __builtin_amdgcn_mfma_f32_16x16x32_bf16(Bt[n][k], At[m][k], acc[ai][bj][m][n], 0, 0, 0); __builtin_amdgcn_s_setprio(0); } while (0)
#define PG8_WAIT_V(n) asm volatile("s_waitcnt vmcnt(" #n ")" ::: "memory")
#define PG8_WAIT_L(n) asm volatile("s_waitcnt lgkmcnt(" #n ")" ::: "memory")
#define PG8_BAR __builtin_amdgcn_s_barrier()
#define PG8_SCHED __builtin_amdgcn_sched_barrier(0)
    Unit cur, nxt; int ui = 0;
    if (!S.next(0, cur)) return;
    f32x4 acc[2][2][4][2];
#pragma unroll
    for (int a = 0; a < 2; ++a)
#pragma unroll
        for (int b = 0; b < 2; ++b)
#pragma unroll
            for (int m = 0; m < 4; ++m)
#pragma unroll
                for (int n = 0; n < 2; ++n) acc[a][b][m][n] = (f32x4){0.f, 0.f, 0.f, 0.f};
    bf16x8 At[4][2], B0[2][2], B1[2][2];
    const char* cA = (const char*)g.A + (size_t)cur.pm * tstep; const char* cB = (const char*)g.Bt + (size_t)cur.pn * tstep;
    S.a_ready(cur);
    if constexpr (SP2) {
        PG8_STAGE(PG8_SB(0, 0), cB, voffB); PG8_STAGE(PG8_SB(0, 1), cB + hstep, voffB); PG8_STAGE(PG8_SA(0, 0), cA, voffA); PG8_STAGE(PG8_SA(0, 1), cA + hstep, voffA);
        if (wr == 1) PG8_BAR;
        PG8_WAIT_V(2); PG8_BAR;
        PG8_STAGE(PG8_SB(1, 0), cB + kstep, voffB); PG8_STAGE(PG8_SA(1, 0), cA + kstep, voffA); PG8_STAGE(PG8_SB(1, 1), cB + hstep + kstep, voffB);
        PG8_WAIT_V(6); PG8_BAR;
    } else {
        PG8_STAGE(PG8_SB(0, 0), cB, voffB); PG8_STAGE(PG8_SA(0, 0), cA, voffA); PG8_STAGE(PG8_SB(0, 1), cB + hstep, voffB); PG8_STAGE(PG8_SA(0, 1), cA + hstep, voffA);
        if (wr == 1) PG8_BAR;
        PG8_WAIT_V(4); PG8_BAR;
        PG8_STAGE(PG8_SB(1, 0), cB + kstep, voffB); PG8_STAGE(PG8_SA(1, 0), cA + kstep, voffA); PG8_STAGE(PG8_SB(1, 1), cB + hstep + kstep, voffB);
        PG8_WAIT_V(6); PG8_BAR;
    }
    for (;;) {
        const bool has_next = S.next(ui + 1, nxt);
        const char* nA = has_next ? (const char*)g.A + (size_t)nxt.pm * tstep : cA; const char* nB = has_next ? (const char*)g.Bt + (size_t)nxt.pn * tstep : cB;
        for (int t = 0; t < nt; t += 2) {
            const bool last = (t == nt - 2);
            const char* a1 = cA + (size_t)(t + 1) * kstep;
            const char* a2 = last ? nA : cA + (size_t)(t + 2) * kstep; const char* b2 = last ? nB : cB + (size_t)(t + 2) * kstep;
            const char* a3 = a2 + kstep; const char* b3 = b2 + kstep;
            if (last && has_next) S.a_ready(nxt);
            if constexpr (SP2) {
            PG8_LDB(B0, 0, 0); PG8_LDB(B1, 0, 1); PG8_SCHED; PG8_LDA(At, 0, 0); PG8_STAGE(PG8_SA(1, 1), a1 + hstep, voffA);
            PG8_WAIT_V(8); PG8_WAIT_L(0); PG8_BAR; PG8_MMA(0, 0, At, B0); PG8_MMA(0, 1, At, B1); PG8_BAR; PG8_SCHED;
            PG8_LDA(At, 0, 1); PG8_STAGE(PG8_SB(0, 0), b2, voffB); PG8_STAGE(PG8_SB(0, 1), b2 + hstep, voffB); PG8_STAGE(PG8_SA(0, 0), a2, voffA);
            PG8_WAIT_V(8); PG8_WAIT_L(0); PG8_BAR; PG8_MMA(1, 0, At, B0); PG8_MMA(1, 1, At, B1); PG8_BAR; PG8_SCHED;
            PG8_LDB(B0, 1, 0); PG8_LDB(B1, 1, 1); PG8_SCHED; PG8_LDA(At, 1, 0); PG8_STAGE(PG8_SA(0, 1), a2 + hstep, voffA);
            PG8_WAIT_V(8); PG8_WAIT_L(0); PG8_BAR; PG8_MMA(0, 0, At, B0); PG8_MMA(0, 1, At, B1); PG8_BAR; PG8_SCHED;
            PG8_LDA(At, 1, 1); PG8_STAGE(PG8_SB(1, 0), b3, voffB); PG8_STAGE(PG8_SB(1, 1), b3 + hstep, voffB); PG8_STAGE(PG8_SA(1, 0), a3, voffA);
            PG8_WAIT_V(8); PG8_WAIT_L(0); PG8_BAR; PG8_MMA(1, 0, At, B0); PG8_MMA(1, 1, At, B1); PG8_BAR; PG8_SCHED;
            } else {
            PG8_LDB(B0, 0, 0); PG8_SCHED; PG8_LDA(At, 0, 0); PG8_STAGE(PG8_SA(1, 1), a1 + hstep, voffA);
            PG8_WAIT_L(8); PG8_BAR; PG8_WAIT_L(0); PG8_MMA(0, 0, At, B0); PG8_BAR; PG8_SCHED;
            PG8_LDB(B1, 0, 1); PG8_STAGE(PG8_SB(0, 0), b2, voffB);
            PG8_BAR; PG8_WAIT_L(0); PG8_MMA(0, 1, At, B1); PG8_BAR;
            PG8_LDA(At, 0, 1); PG8_STAGE(PG8_SA(0, 0), a2, voffA);
            PG8_BAR; PG8_WAIT_L(0); PG8_MMA(1, 0, At, B0); PG8_BAR; PG8_SCHED;
            PG8_STAGE(PG8_SB(0, 1), b2 + hstep, voffB);
            PG8_WAIT_V(6); PG8_BAR; PG8_MMA(1, 1, At, B1); PG8_BAR;
            PG8_LDB(B0, 1, 0); PG8_SCHED; PG8_LDA(At, 1, 0); PG8_STAGE(PG8_SA(0, 1), a2 + hstep, voffA);
            PG8_WAIT_L(8); PG8_BAR; PG8_WAIT_L(0); PG8_MMA(0, 0, At, B0); PG8_BAR; PG8_SCHED;
            PG8_LDB(B1, 1, 1); PG8_STAGE(PG8_SB(1, 0), b3, voffB);
            PG8_BAR; PG8_WAIT_L(0); PG8_MMA(0, 1, At, B1); PG8_BAR;
            PG8_LDA(At, 1, 1); PG8_STAGE(PG8_SA(1, 0), a3, voffA);
            PG8_BAR; PG8_WAIT_L(0); PG8_MMA(1, 0, At, B0); PG8_BAR; PG8_SCHED;
            PG8_STAGE(PG8_SB(1, 1), b3 + hstep, voffB);
            PG8_WAIT_V(6); PG8_BAR; PG8_MMA(1, 1, At, B1); PG8_BAR;
            }
        }
        if constexpr (ALIGN_EPI) { if (wr == 0) PG8_BAR; }
        if constexpr (!Epi::AFTER_DRAIN) { E(acc, cur, wr, wc, fr, fq); S.done(cur); }
        if (!has_next) break;
#pragma unroll
        for (int a = 0; a < 2; ++a)
#pragma unroll
            for (int b = 0; b < 2; ++b)
#pragma unroll
                for (int m = 0; m < 4; ++m)
#pragma unroll
                    for (int n = 0; n < 2; ++n) acc[a][b][m][n] = (f32x4){0.f, 0.f, 0.f, 0.f};
        cur = nxt; cA = nA; cB = nB; ++ui;
        if constexpr (ALIGN_EPI) { if (wr == 1) PG8_BAR; }
    }
    PG8_WAIT_V(0);
    if constexpr (!ALIGN_EPI) { if (wr == 0) PG8_BAR; }
    PG8_BAR;
    if constexpr (Epi::AFTER_DRAIN) { E.fused(acc, cur, wr, wc, fr, fq, lds, wid, lane); S.done(cur); }
#undef PG8_SA
#undef PG8_SB
#undef PG8_STAGE
#undef PG8_LDA
#undef PG8_LDB
#undef PG8_MMA
#undef PG8_WAIT_V
#undef PG8_WAIT_L
#undef PG8_BAR
#undef PG8_SCHED
}
}
#ifndef PG8_SP2
#define PG8_SP2 true
#endif
#ifndef PG8_ALIGN
#define PG8_ALIGN true
#endif
constexpr int NWAVES = 8;
#ifndef MK_N_LAUNCHES
#define MK_N_LAUNCHES 1
#endif
constexpr int NPH = 10;
constexpr int N_LAUNCHES = MK_N_LAUNCHES;

constexpr int BATCH = 2, SEQ = 8192, NMETA = 16, T = SEQ + NMETA, D = 1024, FF = 2816, NIN = 1536, LW = 512, NH = 8, HD = 64;
constexpr int M = BATCH * SEQ;
constexpr float EPS = 1e-6f;

constexpr size_t MiB = 1u << 20, KiB = 1u << 10;
constexpr size_t WS_CTL = 0, CTL_ZERO_BYTES = 1 * MiB;
constexpr size_t WS_XNM = 1 * MiB, WS_HBM = WS_XNM + 64 * KiB, WS_H1ACC = WS_XNM + 192 * KiB, WS_UM = WS_XNM + 256 * KiB;
constexpr size_t WS_SL1 = 2 * MiB, WS_SL2 = 3 * MiB, WS_SL3 = 4 * MiB;
constexpr size_t WS_W1A = 8 * MiB, WS_W1B = WS_W1A + 11 * MiB, WS_WIN = WS_W1B + 11 * MiB / 2, WS_WOUT = WS_WIN + 3 * MiB, WS_W2A = WS_WOUT + 2 * MiB, WS_W2B = WS_W2A + 11 * MiB, WS_WEND = WS_W2B + 11 * MiB / 2;
constexpr size_t WS_HB = 48 * MiB;
constexpr size_t WS_XN = 136 * MiB;
constexpr size_t WS_H1B = 168 * MiB;
constexpr size_t WS_U = 48 * MiB;
constexpr size_t WS_SCR = 96 * MiB;
constexpr size_t WS_G = 162 * MiB;
constexpr size_t WS_YB = 200 * MiB;
constexpr size_t WS_END = 256 * MiB;
static_assert(WS_WEND <= WS_HB && WS_SCR + (size_t)4 * T * 512 * 4 <= WS_G && WS_G + (size_t)2 * T * 512 * 4 <= WS_YB && WS_YB + (size_t)M * D * 2 <= WS_END, "d_ws map");
constexpr int CW_TMO = 0, CW_CODE = 1, CW_BAR = 4096;

constexpr int RING_OFF = 0, RING_BYTES = 131072;
constexpr int LDSCTL_OFF = RING_BYTES, MISC_OFF = LDSCTL_OFF + 320;
constexpr int LDS_BYTES = 147456;

#define GAS __attribute__((address_space(1)))
#define LAS __attribute__((address_space(3)))
typedef unsigned short bf16;
typedef unsigned v4u __attribute__((ext_vector_type(4)));
typedef float f32x4 __attribute__((ext_vector_type(4)));
typedef short bf16x8 __attribute__((ext_vector_type(8)));
typedef GAS unsigned gu32;
#define RLX_AGENT __ATOMIC_RELAXED, __HIP_MEMORY_SCOPE_AGENT
#define LDS_WAIT() asm volatile("s_waitcnt lgkmcnt(0)" ::: "memory")
#define VM_WAIT() asm volatile("s_waitcnt vmcnt(0)" ::: "memory")
__device__ __forceinline__ unsigned f2bf(float f) { unsigned u = __builtin_bit_cast(unsigned, f); return (u + 0x7fffu + ((u >> 16) & 1u)) >> 16; }
__device__ __forceinline__ unsigned pk2(float lo, float hi) { return f2bf(lo) | (f2bf(hi) << 16); }
__device__ __forceinline__ float bf2f(unsigned short b) { return __builtin_bit_cast(float, (unsigned)b << 16); }
__device__ __forceinline__ float wave_sum(float v) {
#pragma unroll
    for (int o = 1; o < 64; o <<= 1) v += __shfl_xor(v, o);
    return v;
}

#define XB_TMO      128
#define XB_XCNT(j)  (256  + 64 * (j))
#define XB_XSUB(j)  (1280 + 64 * (j))
#define XB_XGEN(j)  (2304 + 64 * (j))
#define XB_TOP      3328
#define XB_TOPGEN   3392
#define XCD_BAR_WORDS 3456
#define XB_SPIN_CAP (1u << 18)

__device__ __forceinline__ unsigned xb_ld(unsigned* p)              { return __hip_atomic_load(p, __ATOMIC_RELAXED, __HIP_MEMORY_SCOPE_AGENT); }
__device__ __forceinline__ unsigned xb_add(unsigned* p, unsigned v) { return __hip_atomic_fetch_add(p, v, __ATOMIC_RELAXED, __HIP_MEMORY_SCOPE_AGENT); }
__device__ __forceinline__ unsigned xb_xcc_id() { return (unsigned)__builtin_amdgcn_s_getreg((3 << 11) | 20) & 0xFu; }
#define XB_SPIN(cond, bar) do { unsigned _sp = 0; while (cond) { __builtin_amdgcn_s_sleep(1); \
    if ((++_sp & 255u) == 0u) { if (xb_ld(&(bar)[XB_TMO])) break; if (_sp > XB_SPIN_CAP) { atomicAdd(&(bar)[XB_TMO], 1u); break; } } } } while (0)

struct XcdBarrier {
    unsigned* bar; unsigned x;
    volatile LAS unsigned* st;
};

__device__ __forceinline__ XcdBarrier xcd_barrier_post(unsigned* bar, volatile LAS unsigned* st) {
    XcdBarrier b; b.bar = bar; b.x = xb_xcc_id(); b.st = st;
    if (threadIdx.x == 0) (void)xb_add(&bar[XB_XCNT(b.x)], 1u);
    return b;
}
__device__ __forceinline__ void xcd_barrier_complete(unsigned* bar, unsigned x, unsigned& nloc, unsigned& nx) {
    const unsigned G = gridDim.x * gridDim.y * gridDim.z;
    unsigned sum, cnt, mine, sp = 0u;
    for (;;) {
        sum = 0u; cnt = 0u; mine = 0u;
#pragma unroll
        for (unsigned j = 0; j < 16; ++j) { const unsigned c = xb_ld(&bar[XB_XCNT(j)]); sum += c; cnt += (c > 0u) ? 1u : 0u; mine = (j == x) ? c : mine; }
        if (sum == G) break;
        __builtin_amdgcn_s_sleep(1);
        if ((++sp & 255u) == 0u) { if (xb_ld(&bar[XB_TMO])) break; if (sp > XB_SPIN_CAP) { atomicAdd(&bar[XB_TMO], 1u); break; } }
    }
    nloc = mine > 0u ? mine : 1u; nx = cnt > 0u ? cnt : 1u;
}

__device__ __forceinline__ void xcd_barrier(const XcdBarrier& b) {
    asm volatile("s_waitcnt vmcnt(0)" ::: "memory");
    __syncthreads();
    if (threadIdx.x == 0) {
        unsigned* bar = b.bar;
        __builtin_amdgcn_s_waitcnt(0);
        unsigned nloc = b.st[0], nx = b.st[1];
        if (nloc == 0u) { xcd_barrier_complete(bar, b.x, nloc, nx); b.st[0] = nloc; b.st[1] = nx; }
        const unsigned old = xb_add(&bar[XB_XSUB(b.x)], 1u);
        const unsigned gen = old / nloc;
        if (old + 1u == (gen + 1u) * nloc) {
            __builtin_amdgcn_fence(__ATOMIC_RELEASE, "agent");
            asm volatile("s_waitcnt vmcnt(0)" ::: "memory");
            const unsigned og = xb_add(&bar[XB_TOP], 1u);
            const unsigned tg = og / nx;
            if (og + 1u == (tg + 1u) * nx) xb_add(&bar[XB_TOPGEN], 1u);
            else XB_SPIN(xb_ld(&bar[XB_TOPGEN]) == tg, bar);
            __builtin_amdgcn_fence(__ATOMIC_ACQUIRE, "agent");
            xb_add(&bar[XB_XGEN(b.x)], 1u);
            asm volatile("s_waitcnt vmcnt(0)" ::: "memory");
        } else {
            XB_SPIN(xb_ld(&bar[XB_XGEN(b.x)]) == gen, bar);
            __builtin_amdgcn_fence(__ATOMIC_ACQUIRE, "agent");
            asm volatile("s_waitcnt vmcnt(0)" ::: "memory");
        }
    }
    __syncthreads();
}
struct Frame {
    LAS unsigned char* lds;
    volatile LAS unsigned* MISC;
    gu32* ctl;
    int tid, lane, wave;
    int vcu, G, bx;
    const float* x; const float* meta; float* out;
    const float *g1, *w1a, *w1b, *gmix, *win, *convw, *convb, *waf, *baf, *wxf, *bxf, *lamf, *wab, *bab, *wxb, *bxb, *lamb, *fw, *fb, *glru, *gfour, *wout, *g2, *w2a, *w2b, *gfin;
    bf16 *W1A, *W1B, *WIN, *WOUT, *W2A, *W2B;
    bf16 *XN, *HB, *H1B, *U, *YB, *H2B, *XNM, *HBM, *UM;
    float *H1ACC, *SL1, *SL2, *SL3, *SCR, *GF;
};

__device__ __forceinline__ void p0_transpose_item(const float* W, int ldw, int srcc0, int K, bf16* WT, int dstr0, int k0, const float* ksc, LAS float* scr, int lane) {
#pragma unroll 8
    for (int i = 0; i < 32; ++i) { const int kk = 2 * i + (lane >> 5); float v = W[(size_t)(k0 + kk) * ldw + srcc0 + (lane & 31)]; if (ksc) v *= ksc[k0 + kk]; scr[kk * 33 + (lane & 31)] = v; }
    LDS_WAIT(); asm volatile("" ::: "memory");
    const int c = lane & 7;
#pragma unroll
    for (int j = 0; j < 4; ++j) { const int n = (lane >> 3) + 8 * j; const LAS float* s = scr + (8 * c) * 33 + n;
        v4u o; o.x = pk2(s[0 * 33], s[1 * 33]); o.y = pk2(s[2 * 33], s[3 * 33]); o.z = pk2(s[4 * 33], s[5 * 33]); o.w = pk2(s[6 * 33], s[7 * 33]);
        *(GAS v4u*)(WT + (size_t)(dstr0 + n) * K + k0 + 8 * c) = o; }
    LDS_WAIT(); asm volatile("" ::: "memory");
}
__device__ __forceinline__ void p0_zfold_item(const float* Win, const float* gmix, bf16* WT, int k0, int g, LAS float* scr, int lane) {
    LAS float* tab = scr + 32 * 65;
    tab[lane] = cospif((float)lane * (1.0f / 32.0f));
#pragma unroll 8
    for (int i = 0; i < 32; ++i) scr[i * 65 + lane] = Win[(size_t)(k0 + i) * NIN + 1024 + 64 * g + lane];
    LDS_WAIT(); asm volatile("" ::: "memory");
    const int k = lane & 31, half = lane >> 5;
    float xv[64];
#pragma unroll
    for (int c = 0; c < 64; ++c) xv[c] = scr[k * 65 + c];
    const float gk = gmix[k0 + k];
    for (int j = 0; j < 32; ++j) {
        float acc = 0.f;
#pragma unroll
        for (int c = 0; c < 64; ++c) {
            float w;
            if (half == 0) w = tab[(j * c) & 63];
            else if (j == 0) w = (c & 1) ? -1.0f : 1.0f;
            else w = -tab[(j * c - 16) & 63];
            acc += xv[c] * w;
        }
        WT[(size_t)(1024 + 256 * half + 32 * g + j) * D + k0 + k] = (bf16)f2bf(acc * gk);
    }
    LDS_WAIT(); asm volatile("" ::: "memory");
}
__device__ __forceinline__ void rms_row_to_bf16(const float* xrow, bf16* orow, int lane) {
    const GAS f32x4* xr = (const GAS f32x4*)xrow + lane;
    f32x4 v[4]; float s = 0.f;
#pragma unroll
    for (int j = 0; j < 4; ++j) { v[j] = xr[64 * j]; s += (v[j].x * v[j].x + v[j].y * v[j].y) + (v[j].z * v[j].z + v[j].w * v[j].w); }
    const float rstd = 1.f / sqrtf(wave_sum(s) * (1.f / D) + EPS);
    GAS unsigned long long* o8 = (GAS unsigned long long*)orow + lane;
#pragma unroll
    for (int j = 0; j < 4; ++j) o8[64 * j] = (unsigned long long)pk2(v[j].x * rstd, v[j].y * rstd) | ((unsigned long long)pk2(v[j].z * rstd, v[j].w * rstd) << 32);
}
__device__ __forceinline__ int w1a_srccol(int n0) { const int pn = n0 >> 8, r = n0 & 255; return r < 128 ? 128 * pn + r : FF + 128 * pn + (r - 128); }
__device__ __forceinline__ void p0_prologue(Frame& F) {
    LAS float* scr = (LAS float*)(F.lds + RING_OFF + F.wave * 16384);
    const int gw = F.vcu * NWAVES + F.wave, NGW = F.G * NWAVES;
    constexpr int I_A = (D / 64) * (2 * FF / 32), I_B = (FF / 64) * (D / 32), I_IN = (D / 64) * (1024 / 32), I_Z = (D / 32) * 8, I_O = (D / 64) * (D / 32);
    constexpr int NITEMS = 2 * I_A + 2 * I_B + I_IN + I_Z + I_O;
    for (int it = gw; it < NITEMS; it += NGW) {
        int r = it;
        if (r < I_Z) { p0_zfold_item(F.win, F.gmix, F.WIN, 32 * (r >> 3), r & 7, scr, F.lane); continue; } r -= I_Z;
        if (r < I_A) { const int nb = r % (2 * FF / 32), kb = r / (2 * FF / 32); p0_transpose_item(F.w1a, 2 * FF, w1a_srccol(32 * nb), D, F.W1A, 32 * nb, 64 * kb, F.g1, scr, F.lane); continue; } r -= I_A;
        if (r < I_A) { const int nb = r % (2 * FF / 32), kb = r / (2 * FF / 32); p0_transpose_item(F.w2a, 2 * FF, w1a_srccol(32 * nb), D, F.W2A, 32 * nb, 64 * kb, F.g2, scr, F.lane); continue; } r -= I_A;
        if (r < I_B) { const int nb = r % (D / 32), kb = r / (D / 32); p0_transpose_item(F.w1b, D, 32 * nb, FF, F.W1B, 32 * nb, 64 * kb, nullptr, scr, F.lane); continue; } r -= I_B;
        if (r < I_B) { const int nb = r % (D / 32), kb = r / (D / 32); p0_transpose_item(F.w2b, D, 32 * nb, FF, F.W2B, 32 * nb, 64 * kb, nullptr, scr, F.lane); continue; } r -= I_B;
        if (r < I_IN) { const int nb = r % (1024 / 32), kb = r / (1024 / 32); p0_transpose_item(F.win, NIN, 32 * nb, D, F.WIN, 32 * nb, 64 * kb, F.gmix, scr, F.lane); continue; } r -= I_IN;
        { const int nb = r % (D / 32), kb = r / (D / 32); const int k0 = 64 * kb; p0_transpose_item(F.wout, D, 32 * nb, D, F.WOUT, 32 * nb, k0, k0 < LW ? F.glru : F.gfour - LW, scr, F.lane); }
    }
    for (int m = gw; m < M + NMETA; m += NGW) { if (m < M) rms_row_to_bf16(F.x + (size_t)m * D, F.XN + (size_t)m * D, F.lane); else rms_row_to_bf16(F.meta + (size_t)(m - M) * D, F.XNM + (size_t)(m - M) * D, F.lane); }
    for (int i = gw * 64 + F.lane; i < NMETA * D; i += NGW * 64) F.H1ACC[i] = 0.f;
}

typedef float f32x4m __attribute__((ext_vector_type(4)));
__device__ __forceinline__ bf16x8 ld_frag(const bf16* p) { return *(const bf16x8*)p; }
__device__ __forceinline__ void meta_stage1(Frame& F, int ct) {
    const int fr = F.lane & 15, fq = F.lane >> 4, pn = ct >> 3, within = (ct & 7) * 16;
    const bf16* a = F.XNM + fr * D + 8 * fq; const bf16* bg = F.W1A + (size_t)(256 * pn + within + fr) * D + 8 * fq; const bf16* bu = bg + (size_t)128 * D;
    f32x4 ag = {0.f, 0.f, 0.f, 0.f}, au = {0.f, 0.f, 0.f, 0.f};
#pragma unroll 8
    for (int s = 0; s < D / 32; ++s) { const bf16x8 av = ld_frag(a + 32 * s); ag = __builtin_amdgcn_mfma_f32_16x16x32_bf16(av, ld_frag(bg + 32 * s), ag, 0, 0, 0); au = __builtin_amdgcn_mfma_f32_16x16x32_bf16(av, ld_frag(bu + 32 * s), au, 0, 0, 0); }
#pragma unroll
    for (int r = 0; r < 4; ++r) F.HBM[(4 * fq + r) * FF + 16 * ct + fr] = (bf16)f2bf(pg8::silu_mul(ag[r], au[r]));
}
__device__ __forceinline__ void meta_stage2(Frame& F, int piece) {
    const int fr = F.lane & 15, fq = F.lane >> 4, ct = piece & 63, ks = piece >> 6;
    const bf16* a = F.HBM + fr * FF + 128 * ks + 8 * fq; const bf16* b = F.W1B + (size_t)(16 * ct + fr) * FF + 128 * ks + 8 * fq;
    f32x4 acc = {0.f, 0.f, 0.f, 0.f};
#pragma unroll
    for (int s = 0; s < 4; ++s) acc = __builtin_amdgcn_mfma_f32_16x16x32_bf16(ld_frag(a + 32 * s), ld_frag(b + 32 * s), acc, 0, 0, 0);
#pragma unroll
    for (int r = 0; r < 4; ++r) atomicAdd(F.H1ACC + (4 * fq + r) * D + 16 * ct + fr, acc[r]);
}
__device__ __forceinline__ void meta_stage3(Frame& F, int ct) {
    const int fr = F.lane & 15, fq = F.lane >> 4;
    const float* pm = F.meta + fr * D + 8 * fq; const float* pa = F.H1ACC + fr * D + 8 * fq; const bf16* b = F.WIN + (size_t)(16 * ct + fr) * D + 8 * fq;
    float ss = 0.f;
    for (int s = 0; s < D / 32; ++s) {
#pragma unroll
        for (int j = 0; j < 8; ++j) { const float v = pm[32 * s + j] + 0.5f * __hip_atomic_load(pa + 32 * s + j, RLX_AGENT); ss += v * v; } }
    ss += __shfl_xor(ss, 16); ss += __shfl_xor(ss, 32);
    const float rstd = 1.f / sqrtf(ss * (1.f / D) + EPS);
    f32x4 acc = {0.f, 0.f, 0.f, 0.f};
    for (int s = 0; s < D / 32; ++s) { float v[8];
#pragma unroll
        for (int j = 0; j < 8; ++j) v[j] = (pm[32 * s + j] + 0.5f * __hip_atomic_load(pa + 32 * s + j, RLX_AGENT)) * rstd;
        v4u w; w.x = pk2(v[0], v[1]); w.y = pk2(v[2], v[3]); w.z = pk2(v[4], v[5]); w.w = pk2(v[6], v[7]);
        acc = __builtin_amdgcn_mfma_f32_16x16x32_bf16(__builtin_bit_cast(bf16x8, w), ld_frag(b + 32 * s), acc, 0, 0, 0); }
#pragma unroll
    for (int r = 0; r < 4; ++r) F.UM[(4 * fq + r) * NIN + 16 * ct + fr] = (bf16)f2bf(acc[r]);
}

__device__ __forceinline__ float lru_x_at(const bf16* U, const bf16* UM, int b, int t, int C) {
    if (t < 0 || t >= T) return 0.f;
    return bf2f(t < NMETA ? UM[t * NIN + C] : U[(size_t)(b * SEQ + t - NMETA) * NIN + C]);
}
template <int DIR> __device__ __forceinline__ void naive_scan(const bf16* U, const bf16* UM, const float* Wa, const float* Wx, const float* Ba, const float* Bx, const float* Lam, const float* convw, const float* convb, float* SCR, int b, int h, int lane) {
    const int C = 64 * h + lane;
    float wa[64], wx[64];
#pragma unroll
    for (int k = 0; k < 64; ++k) { wa[k] = Wa[(h * 64 + k) * 64 + lane]; wx[k] = Wx[(h * 64 + k) * 64 + lane]; }
    const float ba = Ba[C], bx = Bx[C], c8 = -8.0f * log1pf(expf(-Lam[C]));
    const float cw0 = convw[C], cw1 = convw[LW + C], cw2 = convw[2 * LW + C], cw3 = convw[3 * LW + C], cb = convb[C];
    float* dst = SCR + (size_t)(DIR * 2 + b) * T * LW + C;
    float hst = 0.f, cur[11], nxt[11];
    { const int tl = DIR ? T - 8 : 0;
#pragma unroll
      for (int i = 0; i < 11; ++i) cur[i] = lru_x_at(U, UM, b, tl - 2 + i, C); }
    for (int blk = 0; blk < T / 8; ++blk) {
        const int tl = DIR ? T - 8 - 8 * blk : 8 * blk, tln = DIR ? tl - 8 : tl + 8;
#pragma unroll
        for (int i = 0; i < 11; ++i) nxt[i] = lru_x_at(U, UM, b, tln - 2 + i, C);
#pragma unroll
        for (int i = 0; i < 8; ++i) { const int ii = DIR ? 7 - i : i; const int t = tl + ii;
            const float xc = cb + cw0 * cur[ii] + cw1 * cur[ii + 1] + cw2 * cur[ii + 2] + cw3 * cur[ii + 3];
            float rp = ba, ip = bx;
#pragma unroll
            for (int k = 0; k < 64; ++k) { const float xk = __builtin_bit_cast(float, __builtin_amdgcn_readlane(__builtin_bit_cast(int, xc), k)); rp += xk * wa[k]; ip += xk * wx[k]; }
            const float r = 1.0f / (1.0f + expf(-rp)), ig = 1.0f / (1.0f + expf(-ip));
            const float la = c8 * r, a = expf(la), mult = sqrtf(-expm1f(2.0f * la));
            hst = a * hst + mult * (ig * xc);
            dst[(size_t)t * LW] = hst; }
#pragma unroll
        for (int i = 0; i < 11; ++i) cur[i] = nxt[i];
    }
}
__device__ __forceinline__ void naive_dft_phase(Frame& F, int first, int nblk) {
    typedef float f32x2v __attribute__((ext_vector_type(2)));
    LAS f32x2v* tab = (LAS f32x2v*)(F.lds + RING_OFF);
    LAS float* red = (LAS float*)(F.lds + RING_OFF + 66 * 1024);
    for (int i = F.tid; i < T; i += NWAVES * 64) { float s, c; sincospif((2.0f * (float)i) / (float)T, &s, &c); tab[i] = (f32x2v){c, s}; }
    __syncthreads();
    const int ch = F.tid & 255, half = F.tid >> 8;
    for (int it = first; it < BATCH * T; it += nblk) {
        const int b = it / T, k = it % T;
        const int t0 = half * (T / 2); int idx = (int)(((long)k * t0) % T);
        float re = 0.f, im = 0.f;
        for (int t = t0; t < t0 + T / 2; ++t) {
            const bf16* p = t < NMETA ? F.UM + t * NIN : F.U + (size_t)(b * SEQ + t - NMETA) * NIN;
            const float zr = bf2f(p[1024 + ch]), zi = bf2f(p[1280 + ch]); const f32x2v w = tab[idx];
            re += zr * w.x + zi * w.y; im += zi * w.x - zr * w.y;
            idx += k; if (idx >= T) idx -= T;
        }
        if (half) { red[ch] = re; red[256 + ch] = im; }
        __syncthreads();
        if (!half) { float* g = F.GF + ((size_t)b * T + k) * 512; g[ch] = re + red[ch]; g[256 + ch] = im + red[256 + ch]; }
        __syncthreads();
    }
}
__device__ __forceinline__ float gelu_tanh(float x) {
    const float z = 1.5957691216057308f * (x + 0.044715f * x * x * x);
    return x / (1.0f + expf(-z));
}
__device__ __forceinline__ void naive_finals(Frame& F) {
    const int gw = F.vcu * NWAVES + F.wave, NGW = F.G * NWAVES, lane = F.lane;
    LAS float* fs = (LAS float*)(F.lds + RING_OFF + F.wave * 4096);
    const float fscale = 1.0f / sqrtf(64.0f * (float)T);
    for (int row = gw; row < M; row += NGW) {
        const int b = row / SEQ, t = NMETA + row % SEQ;
        { const float* hf = F.SCR + ((size_t)(0 * 2 + b) * T + t) * LW + 8 * lane; const float* hb = F.SCR + ((size_t)(1 * 2 + b) * T + t) * LW + 8 * lane;
          const bf16* gp = F.U + (size_t)row * NIN + 512 + 8 * lane; float y[8], ss = 0.f;
#pragma unroll
          for (int j = 0; j < 8; ++j) { y[j] = (hf[j] + hb[j]) * gelu_tanh(bf2f(gp[j])); ss += y[j] * y[j]; }
          const float rstd = 1.f / sqrtf(wave_sum(ss) * (1.f / LW) + EPS);
          v4u w; w.x = pk2(y[0] * rstd, y[1] * rstd); w.y = pk2(y[2] * rstd, y[3] * rstd); w.z = pk2(y[4] * rstd, y[5] * rstd); w.w = pk2(y[6] * rstd, y[7] * rstd);
          *(v4u*)(F.YB + (size_t)row * D + 8 * lane) = w; }
        { const int k = t, kp = T - k; const float* gk = F.GF + ((size_t)b * T + k) * 512; const float* gm = F.GF + ((size_t)b * T + kp) * 512;
#pragma unroll
          for (int i = 0; i < 8; ++i) { const int idx = lane + 64 * i, g = idx >> 6, m = idx & 63; float v;
              if (m == 0) v = 0.5f * (gk[32 * g] + gm[32 * g]);
              else if (m == 32) v = 0.5f * (gk[256 + 32 * g] + gm[256 + 32 * g]);
              else if (m < 32) v = gk[32 * g + m];
              else v = gm[32 * g + 64 - m];
              fs[idx] = v * fscale; }
          LDS_WAIT(); asm volatile("" ::: "memory");
          const int g = lane >> 3, o0 = 8 * (lane & 7); float y[8], ss = 0.f;
#pragma unroll
          for (int j = 0; j < 8; ++j) y[j] = F.fb[64 * g + o0 + j];
          for (int m = 0; m < 64; ++m) { const float fv = fs[64 * g + m]; const float* wp = F.fw + (size_t)(g * 64 + m) * 64 + o0;
#pragma unroll
              for (int j = 0; j < 8; ++j) y[j] += fv * wp[j]; }
#pragma unroll
          for (int j = 0; j < 8; ++j) ss += y[j] * y[j];
          const float rstd = 1.f / sqrtf(wave_sum(ss) * (1.f / LW) + EPS);
          v4u w; w.x = pk2(y[0] * rstd, y[1] * rstd); w.y = pk2(y[2] * rstd, y[3] * rstd); w.z = pk2(y[4] * rstd, y[5] * rstd); w.w = pk2(y[6] * rstd, y[7] * rstd);
          *(v4u*)(F.YB + (size_t)row * D + 512 + 64 * g + o0) = w;
          LDS_WAIT(); asm volatile("" ::: "memory"); }
    }
}
__device__ __forceinline__ void final_norm(Frame& F) {
    const int gw = F.vcu * NWAVES + F.wave, NGW = F.G * NWAVES, lane = F.lane;
    for (int row = gw; row < M; row += NGW) {
        const float rstd = pg8::row_rstd(F.SL3, row);
        GAS f32x4* p = (GAS f32x4*)(F.out + (size_t)row * D) + lane; const GAS f32x4* gp = (const GAS f32x4*)F.gfin + lane;
#pragma unroll
        for (int j = 0; j < 4; ++j) { const f32x4 v = p[64 * j], g = gp[64 * j]; p[64 * j] = v * rstd * g; }
    }
}

struct Args { const float* in[28]; float* out; unsigned char* ws; int ph_lo, ph_hi, li, pad; };
__global__ void __launch_bounds__(NWAVES * 64, 2) fwd_kernel(Args args) {
    extern __shared__ __attribute__((aligned(16))) unsigned char lds[];
    Frame F;
    F.lds = (LAS unsigned char*)lds;
    F.MISC = (volatile LAS unsigned*)(F.lds + MISC_OFF);
    F.tid = threadIdx.x; F.lane = F.tid & 63; F.wave = __builtin_amdgcn_readfirstlane(F.tid >> 6);
    F.G = gridDim.x; F.bx = blockIdx.x; { const int bx = blockIdx.x; F.vcu = (F.G % 8 == 0) ? (bx % 8) * (F.G / 8) + bx / 8 : bx; }
#define GRID_BAR() do { if (N_LAUNCHES == 1) xcd_barrier(bar); } while (0)
    unsigned char* ws = args.ws;
    F.ctl = (gu32*)(ws + WS_CTL);
    F.x = args.in[0]; F.meta = args.in[1]; F.g1 = args.in[2]; F.w1a = args.in[3]; F.w1b = args.in[4]; F.gmix = args.in[5]; F.win = args.in[6]; F.convw = args.in[7]; F.convb = args.in[8];
    F.waf = args.in[9]; F.baf = args.in[10]; F.wxf = args.in[11]; F.bxf = args.in[12]; F.lamf = args.in[13]; F.wab = args.in[14]; F.bab = args.in[15]; F.wxb = args.in[16]; F.bxb = args.in[17]; F.lamb = args.in[18];
    F.fw = args.in[19]; F.fb = args.in[20]; F.glru = args.in[21]; F.gfour = args.in[22]; F.wout = args.in[23]; F.g2 = args.in[24]; F.w2a = args.in[25]; F.w2b = args.in[26]; F.gfin = args.in[27]; F.out = args.out;
    F.W1A = (bf16*)(ws + WS_W1A); F.W1B = (bf16*)(ws + WS_W1B); F.WIN = (bf16*)(ws + WS_WIN); F.WOUT = (bf16*)(ws + WS_WOUT); F.W2A = (bf16*)(ws + WS_W2A); F.W2B = (bf16*)(ws + WS_W2B);
    F.XN = (bf16*)(ws + WS_XN); F.HB = (bf16*)(ws + WS_HB); F.H1B = (bf16*)(ws + WS_H1B); F.U = (bf16*)(ws + WS_U); F.YB = (bf16*)(ws + WS_YB); F.H2B = (bf16*)(ws + WS_H1B);
    F.XNM = (bf16*)(ws + WS_XNM); F.HBM = (bf16*)(ws + WS_HBM); F.UM = (bf16*)(ws + WS_UM); F.H1ACC = (float*)(ws + WS_H1ACC);
    F.SL1 = (float*)(ws + WS_SL1); F.SL2 = (float*)(ws + WS_SL2); F.SL3 = (float*)(ws + WS_SL3); F.SCR = (float*)(ws + WS_SCR); F.GF = (float*)(ws + WS_G);
    for (int u = F.tid; u < (LDS_BYTES - LDSCTL_OFF) / 4; u += NWAVES * 64) ((LAS unsigned*)(F.lds + LDSCTL_OFF))[u] = 0u;
    __syncthreads();
    XcdBarrier bar; bar.bar = (unsigned*)(F.ctl + CW_BAR); bar.x = 0; bar.st = nullptr;
    if (N_LAUNCHES == 1) bar = xcd_barrier_post((unsigned*)(F.ctl + CW_BAR), F.MISC + 8);
    const int lo = args.ph_lo, hi = args.ph_hi;
#define IN(k) (lo <= (k) && (k) < hi)
    const int slack = ((int)blockIdx.x - 128) * NWAVES + F.wave;

    if (IN(0)) { p0_prologue(F); GRID_BAR(); }
    if (IN(1)) {
        if (slack >= 0 && slack < FF / 16) meta_stage1(F, slack);
        pg8::Gemm g{F.XN, F.W1A, M, 2 * FF, D}; pg8::StaticOrder S; S.init(M, 2 * FF, F.G, (int)blockIdx.x);
        pg8::EpiSwiglu E{F.HB, FF, nullptr};
        pg8::gemm_phase<pg8::EpiSwiglu, pg8::StaticOrder, PG8_ALIGN, PG8_SP2>(F.lds + RING_OFF, g, S, E);
        GRID_BAR();
    }
    if (IN(2)) {
        { const int piece = (int)blockIdx.x * NWAVES + F.wave; if (piece < 64 * (FF / 128)) meta_stage2(F, piece); }
        pg8::Gemm g{F.HB, F.W1B, M, D, FF}; pg8::StaticOrder S; S.init(M, D, F.G, (int)blockIdx.x);
        pg8::EpiResid E{F.x, F.out, F.H1B, F.SL1, 0.5f, D};
        pg8::gemm_phase<pg8::EpiResid, pg8::StaticOrder, false, PG8_SP2>(F.lds + RING_OFF, g, S, E);
        GRID_BAR();
    }
    if (IN(3)) {
        if (slack >= 0 && slack < NIN / 16) meta_stage3(F, slack);
        pg8::Gemm g{F.H1B, F.WIN, M, NIN, D}; pg8::StaticOrder S; S.init(M, NIN, F.G, (int)blockIdx.x);
        pg8::EpiScaleBf16 E{F.U, NIN, F.SL1};
        pg8::gemm_phase<pg8::EpiScaleBf16, pg8::StaticOrder, PG8_ALIGN, PG8_SP2>(F.lds + RING_OFF, g, S, E);
        GRID_BAR();
    }
    if (IN(4)) {
        if (blockIdx.x < 32) {
            if (F.wave == 0) { const int it = blockIdx.x, dir = it & 1, h = (it >> 1) & 7, b = it >> 4;
                if (dir == 0) naive_scan<0>(F.U, F.UM, F.waf, F.wxf, F.baf, F.bxf, F.lamf, F.convw, F.convb, F.SCR, b, h, F.lane);
                else naive_scan<1>(F.U, F.UM, F.wab, F.wxb, F.bab, F.bxb, F.lamb, F.convw, F.convb, F.SCR, b, h, F.lane); }
        } else naive_dft_phase(F, (int)blockIdx.x - 32, F.G - 32);
        GRID_BAR();
    }
    if (IN(5)) { naive_finals(F); GRID_BAR(); }
    if (IN(6)) {
        pg8::Gemm g{F.YB, F.WOUT, M, D, D}; pg8::StaticOrder S; S.init(M, D, F.G, (int)blockIdx.x);
        pg8::EpiResid E{F.out, F.out, F.H2B, F.SL2, 1.0f, D};
        pg8::gemm_phase<pg8::EpiResid, pg8::StaticOrder, false, PG8_SP2>(F.lds + RING_OFF, g, S, E);
        GRID_BAR();
    }
    if (IN(7)) {
        pg8::Gemm g{F.H2B, F.W2A, M, 2 * FF, D}; pg8::StaticOrder S; S.init(M, 2 * FF, F.G, (int)blockIdx.x);
        pg8::EpiSwiglu E{F.HB, FF, F.SL2};
        pg8::gemm_phase<pg8::EpiSwiglu, pg8::StaticOrder, PG8_ALIGN, PG8_SP2>(F.lds + RING_OFF, g, S, E);
        GRID_BAR();
    }
    if (IN(8)) {
        pg8::Gemm g{F.HB, F.W2B, M, D, FF}; pg8::StaticOrder S; S.init(M, D, F.G, (int)blockIdx.x);
        pg8::EpiResid E{F.out, F.out, nullptr, F.SL3, 0.5f, D};
        pg8::gemm_phase<pg8::EpiResid, pg8::StaticOrder, false, PG8_SP2>(F.lds + RING_OFF, g, S, E);
        GRID_BAR();
    }
    if (IN(9)) { final_norm(F); }
#undef IN
}

extern "C" void kernel_launch(void* const* d_in, const int* in_sizes, int n_in, void* d_out, int out_size, void* d_ws, size_t ws_size, hipStream_t stream) {
    static int grid = 0;
    if (grid == 0) {
        if (n_in != 28 || out_size != M * D || ws_size < WS_END) { fprintf(stderr, "kernel_launch: unexpected shapes: n_in %d out %d ws %zu\n", n_in, out_size, ws_size); grid = -1; return; }
        int dev = 0, cus = 0;
        if (hipGetDevice(&dev) != hipSuccess || hipDeviceGetAttribute(&cus, hipDeviceAttributeMultiprocessorCount, dev) != hipSuccess) { grid = -1; return; }
        if (hipFuncSetAttribute((const void*)fwd_kernel, hipFuncAttributeMaxDynamicSharedMemorySize, LDS_BYTES) != hipSuccess) { fprintf(stderr, "kernel_launch: hipFuncSetAttribute failed\n"); grid = -1; return; }
        int per_cu = 0;
        if (hipOccupancyMaxActiveBlocksPerMultiprocessor(&per_cu, (const void*)fwd_kernel, NWAVES * 64, LDS_BYTES) != hipSuccess || per_cu < 1) fprintf(stderr, "kernel_launch: occupancy query reports %d\n", per_cu);
        (void)hipGetLastError();
        grid = cus;
        if (grid != 256) fprintf(stderr, "kernel_launch: %d CUs (built for 256)\n", grid);
    }
    if (grid < 0) return;
    if (hipMemsetAsync((char*)d_ws + WS_CTL, 0, CTL_ZERO_BYTES, stream) != hipSuccess) return;
    Args a{};
    for (int i = 0; i < 28; ++i) a.in[i] = (const float*)d_in[i];
    a.out = (float*)d_out; a.ws = (unsigned char*)d_ws;
    if (N_LAUNCHES == 1) { a.ph_lo = 0; a.ph_hi = NPH; a.li = 0; hipLaunchKernelGGL(fwd_kernel, dim3(grid), dim3(NWAVES * 64), LDS_BYTES, stream, a); }
    else for (int li = 0; li < NPH; ++li) { a.ph_lo = li; a.ph_hi = li + 1; a.li = li; hipLaunchKernelGGL(fwd_kernel, dim3(grid), dim3(NWAVES * 64), LDS_BYTES, stream, a); }
}
```

```cpp
#include <hip/hip_runtime.h>
#include <cstdio>
#include <cstdint>
#include <cmath>
namespace pg8 {
#define PG8_LAS __attribute__((address_space(3)))
typedef unsigned short bf16_t;
typedef short bf16x8 __attribute__((ext_vector_type(8)));
typedef float f32x4 __attribute__((ext_vector_type(4)));
typedef unsigned u32x4 __attribute__((ext_vector_type(4)));
constexpr int BM = 256, BK = 64, HALF = 128, HTB = HALF * BK * 2  , STAGE_BYTES = 8 * HTB, NXCD = 8, WGM = 8;

__host__ __device__ __forceinline__ int lds_byte(int r, int c) { const int st = (r >> 4) * 2 + (c >> 5), rr = r & 15, cc = c & 31, ob = rr * 64 + cc * 2; return st * 1024 + (ob ^ (((ob >> 9) & 1) << 5)); }
__host__ __device__ __forceinline__ void stage_rc(int b, int& R, int& C) { const int st = b / 1024, sb = b % 1024, swz = sb ^ (((sb >> 9) & 1) << 5); R = (st >> 1) * 16 + swz / 64; C = (st & 1) * 32 + (swz % 64) / 2; }
__host__ __device__ __forceinline__ int perm32(int rho) { const int n = rho >> 4, i = rho & 15; return 8 * (i >> 2) + 4 * n + (i & 3); }

struct Unit { int pm, pn; };
struct Gemm { const bf16_t* A; const bf16_t* Bt; int M, N, K; };

struct StaticOrder {
    int nM, nN, nwg, G, c;
    __host__ __device__ void init(int M, int N, int G_, int c_) { nM = M / BM; nN = N / BM; nwg = nM * nN; G = G_; c = c_; }
    __host__ __device__ bool next(int i, Unit& u) const {
        const long L = (long)i * G + c; if (L >= nwg) return false;
        int wgid = (int)L; { const int q = nwg / NXCD, r = nwg % NXCD, xcd = wgid % NXCD, off = wgid / NXCD; wgid = (xcd < r ? xcd * (q + 1) : r * (q + 1) + (xcd - r) * q) + off; }
        const int nig = WGM * nN, gid = wgid / nig, fm = gid * WGM, gsz = (nM - fm) < WGM ? (nM - fm) : WGM;
        u.pm = fm + ((wgid % nig) % gsz); u.pn = (wgid % nig) / gsz; return true;
    }
    __device__ __forceinline__ void a_ready(const Unit&) const {}
    __device__ __forceinline__ void done(const Unit&) const {}
};

__device__ __forceinline__ unsigned cvt_pk_bf16(float lo, float hi) { unsigned r; asm volatile("v_cvt_pk_bf16_f32 %0, %1, %2" : "=v"(r) : "v"(lo), "v"(hi)); return r; }
typedef unsigned u32x2 __attribute__((ext_vector_type(2)));
constexpr float RMS_EPS = 1e-6f;
__device__ __forceinline__ float row_rstd(const float* slots, int r) {
    const f32x4* p = (const f32x4*)(slots + (size_t)r * 16);
    const f32x4 a = p[0], b = p[1], c = p[2], d = p[3];
    const float s = (((a[0] + a[1]) + (a[2] + a[3])) + ((b[0] + b[1]) + (b[2] + b[3]))) + (((c[0] + c[1]) + (c[2] + c[3])) + ((d[0] + d[1]) + (d[2] + d[3])));
    return 1.0f / sqrtf(s * (1.0f / 1024.0f) + RMS_EPS);
}
__device__ __forceinline__ float silu_mul(float g, float u) {
    const float e = __builtin_amdgcn_exp2f(g * -1.44269504089f);
    return g * __builtin_amdgcn_rcpf(1.0f + e) * u;
}
struct EpiSwiglu {
    static constexpr bool PERM = true, AFTER_DRAIN = false;
    bf16_t* O; int ldc; const float* slots;
    __device__ __forceinline__ void operator()(const f32x4 (&acc)[2][2][4][2], const Unit& u, int wr, int wc, int fr, int fq) const {
        const int row0 = u.pm * BM + wr * 64 + fr, col0 = u.pn * HALF + wc * 32 + 8 * fq;
#pragma unroll
        for (int ai = 0; ai < 2; ++ai)
#pragma unroll
            for (int m = 0; m < 4; ++m) { const int r = row0 + ai * HALF + m * 16; const float s = slots ? row_rstd(slots, r) : 1.0f;
                const f32x4 g0 = acc[ai][0][m][0] * s, g1 = acc[ai][0][m][1] * s, u0 = acc[ai][1][m][0] * s, u1 = acc[ai][1][m][1] * s;
                u32x4 w; w.x = cvt_pk_bf16(silu_mul(g0[0], u0[0]), silu_mul(g0[1], u0[1])); w.y = cvt_pk_bf16(silu_mul(g0[2], u0[2]), silu_mul(g0[3], u0[3]));
                w.z = cvt_pk_bf16(silu_mul(g1[0], u1[0]), silu_mul(g1[1], u1[1])); w.w = cvt_pk_bf16(silu_mul(g1[2], u1[2]), silu_mul(g1[3], u1[3]));
                *(u32x4*)(O + (size_t)r * ldc + col0) = w; }
    }
};
struct EpiScaleBf16 {
    static constexpr bool PERM = true, AFTER_DRAIN = false;
    bf16_t* O; int ldc; const float* slots;
    __device__ __forceinline__ void operator()(const f32x4 (&acc)[2][2][4][2], const Unit& u, int wr, int wc, int fr, int fq) const {
        const int row0 = u.pm * BM + wr * 64 + fr, col0 = u.pn * BM + wc * 32 + 8 * fq;
#pragma unroll
        for (int ai = 0; ai < 2; ++ai)
#pragma unroll
            for (int m = 0; m < 4; ++m) { const int r = row0 + ai * HALF + m * 16; const float s = row_rstd(slots, r); bf16_t* rowp = O + (size_t)r * ldc + col0;
#pragma unroll
                for (int bj = 0; bj < 2; ++bj) { const f32x4 v0 = acc[ai][bj][m][0] * s, v1 = acc[ai][bj][m][1] * s;
                    u32x4 w; w.x = cvt_pk_bf16(v0[0], v0[1]); w.y = cvt_pk_bf16(v0[2], v0[3]); w.z = cvt_pk_bf16(v1[0], v1[1]); w.w = cvt_pk_bf16(v1[2], v1[3]);
                    *(u32x4*)(rowp + bj * HALF) = w; } }
    }
};
struct EpiResid {
    static constexpr bool PERM = false, AFTER_DRAIN = false;
    const float* base; float* out; bf16_t* ob; float* slots; float alpha; int ldc;
    __device__ __forceinline__ void operator()(const f32x4 (&acc)[2][2][4][2], const Unit& u, int wr, int wc, int fr, int fq) const {
        const int row0 = u.pm * BM + wr * 64 + fr, col0 = u.pn * BM + wc * 32 + 4 * fq;
#pragma unroll
        for (int ai = 0; ai < 2; ++ai)
#pragma unroll
            for (int m = 0; m < 4; ++m) { const int r = row0 + ai * HALF + m * 16; const size_t off = (size_t)r * ldc + col0; float ss = 0.f;
#pragma unroll
                for (int bj = 0; bj < 2; ++bj)
#pragma unroll
                    for (int n = 0; n < 2; ++n) { const size_t o = off + bj * HALF + n * 16; const f32x4 b = *(const f32x4*)(base + o); const f32x4 v = b + acc[ai][bj][m][n] * alpha;
                        *(f32x4*)(out + o) = v; ss += (v[0] * v[0] + v[1] * v[1]) + (v[2] * v[2] + v[3] * v[3]);
                        if (ob) { u32x2 w; w.x = cvt_pk_bf16(v[0], v[1]); w.y = cvt_pk_bf16(v[2], v[3]); *(u32x2*)(ob + o) = w; } }
                ss += __shfl_xor(ss, 16); ss += __shfl_xor(ss, 32);
                if (fq == 0) slots[(size_t)r * 16 + u.pn * 4 + wc] = ss; }
    }
};

template <class Epi, class Sched, bool ALIGN_EPI = false, bool SP2 = false>
__device__ __forceinline__ void gemm_phase(PG8_LAS unsigned char* lds, const Gemm g, const Sched& S, const Epi& E) {
    const int tid = threadIdx.x, wid = __builtin_amdgcn_readfirstlane(tid >> 6), lane = tid & 63, wr = wid >> 2, wc = wid & 3, fr = lane & 15, fq = lane >> 4;
    const int K = g.K, nt = K / BK;
    unsigned voffA[2], voffB[2];
#pragma unroll
    for (int i = 0; i < 2; ++i) { int R, C; stage_rc(tid * 16 + i * 8192, R, C); const int Rb = Epi::PERM ? ((R & ~31) + perm32(R & 31)) : R;
        voffA[i] = (unsigned)(R * K + C) * 2u; voffB[i] = (unsigned)(Rb * K + C) * 2u; }
    const size_t kstep = (size_t)(BK * 2);
    const size_t hstep = (size_t)HALF * K * 2;
    const size_t tstep = 2 * hstep;
    const unsigned ldsw = (unsigned)wid * 1024u;
    const int aoff = lds_byte(wr * 64 + fr, fq * 8), boff = lds_byte(wc * 32 + fr, fq * 8);
#define PG8_SA(b, h) (((b) * 2 + (h)) * HTB)
#define PG8_SB(b, h) ((4 + (b) * 2 + (h)) * HTB)
#define PG8_STAGE(bufoff, gbase, voff) do { _Pragma("unroll") for (int _i = 0; _i < 2; ++_i) \
        __builtin_amdgcn_global_load_lds((const unsigned*)((const char*)(gbase) + (voff)[_i]), (PG8_LAS unsigned*)(lds + (bufoff) + ldsw + _i * 8192), 16, 0, 0); } while (0)
#define PG8_LDA(dst, b, h) do { _Pragma("unroll") for (int m = 0; m < 4; ++m) _Pragma("unroll") for (int k = 0; k < 2; ++k) dst[m][k] = *(const PG8_LAS bf16x8*)(lds + PG8_SA(b, h) + aoff + m * 2048 + k * 1024); } while (0)
#define PG8_LDB(dst, b, h) do { _Pragma("unroll") for (int n = 0; n < 2; ++n) _Pragma("unroll") for (int k = 0; k < 2; ++k) dst[n][k] = *(const PG8_LAS bf16x8*)(lds + PG8_SB(b, h) + boff + n * 2048 + k * 1024); } while (0)
#define PG8_MMA(ai, bj, At, Bt) do { __builtin_amdgcn_s_setprio(1); _Pragma("unroll") for (int m = 0; m < 4; ++m) _Pragma("unroll") for (int n = 0; n < 2; ++n) _Pragma("unroll") for (int k = 0; k < 2; ++k) \
        acc[ai][bj][m][n] = __builtin_amdgcn_mfma_f32_16x16x32_bf16(Bt[n][k], At[m][k], acc[ai][bj][m][n], 0, 0, 0); __builtin_amdgcn_s_setprio(0); } while (0)
#define PG8_WAIT_V(n) asm volatile("s_waitcnt vmcnt(" #n ")" ::: "memory")
#define PG8_WAIT_L(n) asm volatile("s_waitcnt lgkmcnt(" #n ")" ::: "memory")
#define PG8_BAR __builtin_amdgcn_s_barrier()
#define PG8_SCHED __builtin_amdgcn_sched_barrier(0)
    Unit cur, nxt; int ui = 0;
    if (!S.next(0, cur)) return;
    f32x4 acc[2][2][4][2];
#pragma unroll
    for (int a = 0; a < 2; ++a)
#pragma unroll
        for (int b = 0; b < 2; ++b)
#pragma unroll
            for (int m = 0; m < 4; ++m)
#pragma unroll
                for (int n = 0; n < 2; ++n) acc[a][b][m][n] = (f32x4){0.f, 0.f, 0.f, 0.f};
    bf16x8 At[4][2], B0[2][2], B1[2][2];
    const char* cA = (const char*)g.A + (size_t)cur.pm * tstep; const char* cB = (const char*)g.Bt + (size_t)cur.pn * tstep;
    S.a_ready(cur);
    if constexpr (SP2) {
        PG8_STAGE(PG8_SB(0, 0), cB, voffB); PG8_STAGE(PG8_SB(0, 1), cB + hstep, voffB); PG8_STAGE(PG8_SA(0, 0), cA, voffA); PG8_STAGE(PG8_SA(0, 1), cA + hstep, voffA);
        if (wr == 1) PG8_BAR;
        PG8_WAIT_V(2); PG8_BAR;
        PG8_STAGE(PG8_SB(1, 0), cB + kstep, voffB); PG8_STAGE(PG8_SA(1, 0), cA + kstep, voffA); PG8_STAGE(PG8_SB(1, 1), cB + hstep + kstep, voffB);
        PG8_WAIT_V(6); PG8_BAR;
    } else {
        PG8_STAGE(PG8_SB(0, 0), cB, voffB); PG8_STAGE(PG8_SA(0, 0), cA, voffA); PG8_STAGE(PG8_SB(0, 1), cB + hstep, voffB); PG8_STAGE(PG8_SA(0, 1), cA + hstep, voffA);
        if (wr == 1) PG8_BAR;
        PG8_WAIT_V(4); PG8_BAR;
        PG8_STAGE(PG8_SB(1, 0), cB + kstep, voffB); PG8_STAGE(PG8_SA(1, 0), cA + kstep, voffA); PG8_STAGE(PG8_SB(1, 1), cB + hstep + kstep, voffB);
        PG8_WAIT_V(6); PG8_BAR;
    }
    for (;;) {
        const bool has_next = S.next(ui + 1, nxt);
        const char* nA = has_next ? (const char*)g.A + (size_t)nxt.pm * tstep : cA; const char* nB = has_next ? (const char*)g.Bt + (size_t)nxt.pn * tstep : cB;
        for (int t = 0; t < nt; t += 2) {
            const bool last = (t == nt - 2);
            const char* a1 = cA + (size_t)(t + 1) * kstep;
            const char* a2 = last ? nA : cA + (size_t)(t + 2) * kstep; const char* b2 = last ? nB : cB + (size_t)(t + 2) * kstep;
            const char* a3 = a2 + kstep; const char* b3 = b2 + kstep;
            if (last && has_next) S.a_ready(nxt);
            if constexpr (SP2) {
            PG8_LDB(B0, 0, 0); PG8_LDB(B1, 0, 1); PG8_SCHED; PG8_LDA(At, 0, 0); PG8_STAGE(PG8_SA(1, 1), a1 + hstep, voffA);
            PG8_WAIT_V(8); PG8_WAIT_L(0); PG8_BAR; PG8_MMA(0, 0, At, B0); PG8_MMA(0, 1, At, B1); PG8_BAR; PG8_SCHED;
            PG8_LDA(At, 0, 1); PG8_STAGE(PG8_SB(0, 0), b2, voffB); PG8_STAGE(PG8_SB(0, 1), b2 + hstep, voffB); PG8_STAGE(PG8_SA(0, 0), a2, voffA);
            PG8_WAIT_V(8); PG8_WAIT_L(0); PG8_BAR; PG8_MMA(1, 0, At, B0); PG8_MMA(1, 1, At, B1); PG8_BAR; PG8_SCHED;
            PG8_LDB(B0, 1, 0); PG8_LDB(B1, 1, 1); PG8_SCHED; PG8_LDA(At, 1, 0); PG8_STAGE(PG8_SA(0, 1), a2 + hstep, voffA);
            PG8_WAIT_V(8); PG8_WAIT_L(0); PG8_BAR; PG8_MMA(0, 0, At, B0); PG8_MMA(0, 1, At, B1); PG8_BAR; PG8_SCHED;
            PG8_LDA(At, 1, 1); PG8_STAGE(PG8_SB(1, 0), b3, voffB); PG8_STAGE(PG8_SB(1, 1), b3 + hstep, voffB); PG8_STAGE(PG8_SA(1, 0), a3, voffA);
            PG8_WAIT_V(8); PG8_WAIT_L(0); PG8_BAR; PG8_MMA(1, 0, At, B0); PG8_MMA(1, 1, At, B1); PG8_BAR; PG8_SCHED;
            } else {
            PG8_LDB(B0, 0, 0); PG8_SCHED; PG8_LDA(At, 0, 0); PG8_STAGE(PG8_SA(1, 1), a1 + hstep, voffA);
            PG8_WAIT_L(8); PG8_BAR; PG8_WAIT_L(0); PG8_MMA(0, 0, At, B0); PG8_BAR; PG8_SCHED;
            PG8_LDB(B1, 0, 1); PG8_STAGE(PG8_SB(0, 0), b2, voffB);
            PG8_BAR; PG8_WAIT_L(0); PG8_MMA(0, 1, At, B1); PG8_BAR;
            PG8_LDA(At, 0, 1); PG8_STAGE(PG8_SA(0, 0), a2, voffA);
            PG8_BAR; PG8_WAIT_L(0); PG8_MMA(1, 0, At, B0); PG8_BAR; PG8_SCHED;
            PG8_STAGE(PG8_SB(0, 1), b2 + hstep, voffB);
            PG8_WAIT_V(6); PG8_BAR; PG8_MMA(1, 1, At, B1); PG8_BAR;
            PG8_LDB(B0, 1, 0); PG8_SCHED; PG8_LDA(At, 1, 0); PG8_STAGE(PG8_SA(0, 1), a2 + hstep, voffA);
            PG8_WAIT_L(8); PG8_BAR; PG8_WAIT_L(0); PG8_MMA(0, 0, At, B0); PG8_BAR; PG8_SCHED;
            PG8_LDB(B1, 1, 1); PG8_STAGE(PG8_SB(1, 0), b3, voffB);
            PG8_BAR; PG8_WAIT_L(0); PG8_MMA(0, 1, At, B1); PG8_BAR;
            PG8_LDA(At, 1, 1); PG8_STAGE(PG8_SA(1, 0), a3, voffA);
            PG8_BAR; PG8_WAIT_L(0); PG8_MMA(1, 0, At, B0); PG8_BAR; PG8_SCHED;
            PG8_STAGE(PG8_SB(1, 1), b3 + hstep, voffB);
            PG8_WAIT_V(6); PG8_BAR; PG8_MMA(1, 1, At, B1); PG8_BAR;
            }
        }
        if constexpr (ALIGN_EPI) { if (wr == 0) PG8_BAR; }
        if constexpr (!Epi::AFTER_DRAIN) { E(acc, cur, wr, wc, fr, fq); S.done(cur); }
        if (!has_next) break;
#pragma unroll
        for (int a = 0; a < 2; ++a)
#pragma unroll
            for (int b = 0; b < 2; ++b)
#pragma unroll
                for (int m = 0; m < 4; ++m)
#pragma unroll
                    for (int n = 0; n < 2; ++n) acc[a][b][m][n] = (f32x4){0.f, 0.f, 0.f, 0.f};
        cur = nxt; cA = nA; cB = nB; ++ui;
        if constexpr (ALIGN_EPI) { if (wr == 1) PG8_BAR; }
    }
    PG8_WAIT_V(0);
    if constexpr (!ALIGN_EPI) { if (wr == 0) PG8_BAR; }
    PG8_BAR;
    if constexpr (Epi::AFTER_DRAIN) { E.fused(acc, cur, wr, wc, fr, fq, lds, wid, lane); S.done(cur); }
#undef PG8_SA
#undef PG8_SB
#undef PG8_STAGE
#undef PG8_LDA
#undef PG8_LDB
#undef PG8_MMA
#undef PG8_WAIT_V
#undef PG8_WAIT_L
#undef PG8_BAR
#undef PG8_SCHED
}
}
#ifndef PG8_SP2
#define PG8_SP2 true
#endif
#ifndef PG8_ALIGN
#define PG8_ALIGN true
#endif
constexpr int NWAVES = 8;
#ifndef MK_N_LAUNCHES
#define MK_N_LAUNCHES 1
#endif
constexpr int NPH = 11;
constexpr int N_LAUNCHES = MK_N_LAUNCHES;

constexpr int BATCH = 2, SEQ = 8192, NMETA = 16, T = SEQ + NMETA, D = 1024, FF = 2816, NIN = 1536, LW = 512, NH = 8, HD = 64;
constexpr int M = BATCH * SEQ;
constexpr float EPS = 1e-6f;

constexpr size_t MiB = 1u << 20, KiB = 1u << 10;
constexpr size_t WS_CTL = 0, CTL_ZERO_BYTES = 1 * MiB;
constexpr size_t WS_XNM = 1 * MiB, WS_HBM = WS_XNM + 64 * KiB, WS_H1ACC = WS_XNM + 192 * KiB, WS_UM = WS_XNM + 256 * KiB;
constexpr size_t WS_SL1 = 2 * MiB, WS_SL2 = 3 * MiB, WS_SL3 = 4 * MiB;
constexpr size_t WS_W1A = 8 * MiB, WS_W1B = WS_W1A + 11 * MiB, WS_WIN = WS_W1B + 11 * MiB / 2, WS_WOUT = WS_WIN + 3 * MiB, WS_W2A = WS_WOUT + 2 * MiB, WS_W2B = WS_W2A + 11 * MiB, WS_WEND = WS_W2B + 11 * MiB / 2;
constexpr size_t WS_HB = 48 * MiB;
constexpr size_t WS_XN = 136 * MiB;
constexpr size_t WS_H1B = 168 * MiB;
constexpr size_t WS_U = 48 * MiB;
constexpr size_t WS_WG = 6 * MiB, WS_CAR = WS_WG + 512 * KiB;
constexpr size_t WS_SUM = 96 * MiB;
constexpr size_t WS_G = 162 * MiB;
constexpr size_t WS_Y = 232 * MiB;
constexpr size_t WS_A1 = 5 * MiB, WS_TW = WS_A1 + 192 * KiB, WS_A2 = WS_A1 + 320 * KiB, WS_WF2 = WS_A1 + 384 * KiB;
constexpr size_t WS_YB = 200 * MiB;
constexpr size_t WS_END = 256 * MiB;
static_assert(WS_WEND <= WS_HB && WS_G + (size_t)2 * T * 512 * 4 <= WS_YB && WS_YB + (size_t)M * D * 2 <= WS_END, "d_ws map");
constexpr int CW_TMO = 0, CW_CODE = 1, CW_BAR = 4096;

constexpr int RING_OFF = 0, RING_BYTES = 131072;
constexpr int LDSCTL_OFF = 146432, MISC_OFF = LDSCTL_OFF + 320;
constexpr int LDS_BYTES = 147456;

#define GAS __attribute__((address_space(1)))
#define LAS __attribute__((address_space(3)))
typedef unsigned short bf16;
typedef unsigned v4u __attribute__((ext_vector_type(4)));
typedef float f32x4 __attribute__((ext_vector_type(4)));
typedef short bf16x8 __attribute__((ext_vector_type(8)));
typedef GAS unsigned gu32;
#define RLX_AGENT __ATOMIC_RELAXED, __HIP_MEMORY_SCOPE_AGENT
#define LDS_WAIT() asm volatile("s_waitcnt lgkmcnt(0)" ::: "memory")
#define VM_WAIT() asm volatile("s_waitcnt vmcnt(0)" ::: "memory")
__device__ __forceinline__ unsigned f2bf(float f) { unsigned u = __builtin_bit_cast(unsigned, f); return (u + 0x7fffu + ((u >> 16) & 1u)) >> 16; }
__device__ __forceinline__ unsigned pk2(float lo, float hi) { return f2bf(lo) | (f2bf(hi) << 16); }
__device__ __forceinline__ float bf2f(unsigned short b) { return __builtin_bit_cast(float, (unsigned)b << 16); }
__device__ __forceinline__ float wave_sum(float v) {
#pragma unroll
    for (int o = 1; o < 64; o <<= 1) v += __shfl_xor(v, o);
    return v;
}

#define XB_TMO      128
#define XB_XCNT(j)  (256  + 64 * (j))
#define XB_XSUB(j)  (1280 + 64 * (j))
#define XB_XGEN(j)  (2304 + 64 * (j))
#define XB_TOP      3328
#define XB_TOPGEN   3392
#define XCD_BAR_WORDS 3456
#define XB_SPIN_CAP (1u << 18)

__device__ __forceinline__ unsigned xb_ld(unsigned* p)              { return __hip_atomic_load(p, __ATOMIC_RELAXED, __HIP_MEMORY_SCOPE_AGENT); }
__device__ __forceinline__ unsigned xb_add(unsigned* p, unsigned v) { return __hip_atomic_fetch_add(p, v, __ATOMIC_RELAXED, __HIP_MEMORY_SCOPE_AGENT); }
__device__ __forceinline__ unsigned xb_xcc_id() { return (unsigned)__builtin_amdgcn_s_getreg((3 << 11) | 20) & 0xFu; }
#define XB_SPIN(cond, bar) do { unsigned _sp = 0; while (cond) { __builtin_amdgcn_s_sleep(1); \
    if ((++_sp & 255u) == 0u) { if (xb_ld(&(bar)[XB_TMO])) break; if (_sp > XB_SPIN_CAP) { atomicAdd(&(bar)[XB_TMO], 1u); break; } } } } while (0)

struct XcdBarrier {
    unsigned* bar; unsigned x;
    volatile LAS unsigned* st;
};

__device__ __forceinline__ XcdBarrier xcd_barrier_post(unsigned* bar, volatile LAS unsigned* st) {
    XcdBarrier b; b.bar = bar; b.x = xb_xcc_id(); b.st = st;
    if (threadIdx.x == 0) (void)xb_add(&bar[XB_XCNT(b.x)], 1u);
    return b;
}
__device__ __forceinline__ void xcd_barrier_complete(unsigned* bar, unsigned x, unsigned& nloc, unsigned& nx) {
    const unsigned G = gridDim.x * gridDim.y * gridDim.z;
    unsigned sum, cnt, mine, sp = 0u;
    for (;;) {
        sum = 0u; cnt = 0u; mine = 0u;
#pragma unroll
        for (unsigned j = 0; j < 16; ++j) { const unsigned c = xb_ld(&bar[XB_XCNT(j)]); sum += c; cnt += (c > 0u) ? 1u : 0u; mine = (j == x) ? c : mine; }
        if (sum == G) break;
        __builtin_amdgcn_s_sleep(1);
        if ((++sp & 255u) == 0u) { if (xb_ld(&bar[XB_TMO])) break; if (sp > XB_SPIN_CAP) { atomicAdd(&bar[XB_TMO], 1u); break; } }
    }
    nloc = mine > 0u ? mine : 1u; nx = cnt > 0u ? cnt : 1u;
}

__device__ __forceinline__ void xcd_barrier(const XcdBarrier& b) {
    asm volatile("s_waitcnt vmcnt(0)" ::: "memory");
    __syncthreads();
    if (threadIdx.x == 0) {
        unsigned* bar = b.bar;
        __builtin_amdgcn_s_waitcnt(0);
        unsigned nloc = b.st[0], nx = b.st[1];
        if (nloc == 0u) { xcd_barrier_complete(bar, b.x, nloc, nx); b.st[0] = nloc; b.st[1] = nx; }
        const unsigned old = xb_add(&bar[XB_XSUB(b.x)], 1u);
        const unsigned gen = old / nloc;
        if (old + 1u == (gen + 1u) * nloc) {
            __builtin_amdgcn_fence(__ATOMIC_RELEASE, "agent");
            asm volatile("s_waitcnt vmcnt(0)" ::: "memory");
            const unsigned og = xb_add(&bar[XB_TOP], 1u);
            const unsigned tg = og / nx;
            if (og + 1u == (tg + 1u) * nx) xb_add(&bar[XB_TOPGEN], 1u);
            else XB_SPIN(xb_ld(&bar[XB_TOPGEN]) == tg, bar);
            __builtin_amdgcn_fence(__ATOMIC_ACQUIRE, "agent");
            xb_add(&bar[XB_XGEN(b.x)], 1u);
            asm volatile("s_waitcnt vmcnt(0)" ::: "memory");
        } else {
            XB_SPIN(xb_ld(&bar[XB_XGEN(b.x)]) == gen, bar);
            __builtin_amdgcn_fence(__ATOMIC_ACQUIRE, "agent");
            asm volatile("s_waitcnt vmcnt(0)" ::: "memory");
        }
    }
    __syncthreads();
}
struct Frame {
    LAS unsigned char* lds;
    volatile LAS unsigned* MISC;
    gu32* ctl;
    int tid, lane, wave;
    int vcu, G, bx;
    const float* x; const float* meta; float* out;
    const float *g1, *w1a, *w1b, *gmix, *win, *convw, *convb, *waf, *baf, *wxf, *bxf, *lamf, *wab, *bab, *wxb, *bxb, *lamb, *fw, *fb, *glru, *gfour, *wout, *g2, *w2a, *w2b, *gfin;
    bf16 *W1A, *W1B, *WIN, *WOUT, *W2A, *W2B;
    bf16 *XN, *HB, *H1B, *U, *YB, *H2B, *XNM, *HBM, *UM;
    float *H1ACC, *SL1, *SL2, *SL3;
    bf16 *A1, *A2, *WF2, *Y, *GB, *WG; float *TW, *SUM, *CAR;
};

__device__ __forceinline__ void p0_transpose_item(const float* W, int ldw, int srcc0, int K, bf16* WT, int dstr0, int k0, const float* ksc, LAS float* scr, int lane) {
#pragma unroll 8
    for (int i = 0; i < 32; ++i) { const int kk = 2 * i + (lane >> 5); float v = W[(size_t)(k0 + kk) * ldw + srcc0 + (lane & 31)]; if (ksc) v *= ksc[k0 + kk]; scr[kk * 33 + (lane & 31)] = v; }
    LDS_WAIT(); asm volatile("" ::: "memory");
    const int c = lane & 7;
#pragma unroll
    for (int j = 0; j < 4; ++j) { const int n = (lane >> 3) + 8 * j; const LAS float* s = scr + (8 * c) * 33 + n;
        v4u o; o.x = pk2(s[0 * 33], s[1 * 33]); o.y = pk2(s[2 * 33], s[3 * 33]); o.z = pk2(s[4 * 33], s[5 * 33]); o.w = pk2(s[6 * 33], s[7 * 33]);
        *(GAS v4u*)(WT + (size_t)(dstr0 + n) * K + k0 + 8 * c) = o; }
    LDS_WAIT(); asm volatile("" ::: "memory");
}
__device__ __forceinline__ void p0_zfold_item(const float* Win, const float* gmix, bf16* WT, int k0, int g, LAS float* scr, int lane) {
    LAS float* tab = scr + 32 * 65;
    tab[lane] = cospif((float)lane * (1.0f / 32.0f));
#pragma unroll 8
    for (int i = 0; i < 32; ++i) scr[i * 65 + lane] = Win[(size_t)(k0 + i) * NIN + 1024 + 64 * g + lane];
    LDS_WAIT(); asm volatile("" ::: "memory");
    const int k = lane & 31, half = lane >> 5;
    float xv[64];
#pragma unroll
    for (int c = 0; c < 64; ++c) xv[c] = scr[k * 65 + c];
    const float gk = gmix[k0 + k];
    for (int j = 0; j < 32; ++j) {
        float acc = 0.f;
#pragma unroll
        for (int c = 0; c < 64; ++c) {
            float w;
            if (half == 0) w = tab[(j * c) & 63];
            else if (j == 0) w = (c & 1) ? -1.0f : 1.0f;
            else w = -tab[(j * c - 16) & 63];
            acc += xv[c] * w;
        }
        WT[(size_t)(1024 + 256 * half + 32 * g + j) * D + k0 + k] = (bf16)f2bf(acc * gk);
    }
    LDS_WAIT(); asm volatile("" ::: "memory");
}
__device__ __forceinline__ void rms_row_to_bf16(const float* xrow, bf16* orow, int lane) {
    const GAS f32x4* xr = (const GAS f32x4*)xrow + lane;
    f32x4 v[4]; float s = 0.f;
#pragma unroll
    for (int j = 0; j < 4; ++j) { v[j] = xr[64 * j]; s += (v[j].x * v[j].x + v[j].y * v[j].y) + (v[j].z * v[j].z + v[j].w * v[j].w); }
    const float rstd = 1.f / sqrtf(wave_sum(s) * (1.f / D) + EPS);
    GAS unsigned long long* o8 = (GAS unsigned long long*)orow + lane;
#pragma unroll
    for (int j = 0; j < 4; ++j) o8[64 * j] = (unsigned long long)pk2(v[j].x * rstd, v[j].y * rstd) | ((unsigned long long)pk2(v[j].z * rstd, v[j].w * rstd) << 32);
}
__device__ __forceinline__ int w1a_srccol(int n0) { const int pn = n0 >> 8, r = n0 & 255; return r < 128 ? 128 * pn + r : FF + 128 * pn + (r - 128); }
__device__ __forceinline__ void p0_prologue(Frame& F) {
    LAS float* scr = (LAS float*)(F.lds + RING_OFF + F.wave * 16384);
    const int gw = F.vcu * NWAVES + F.wave, NGW = F.G * NWAVES;
    constexpr int I_A = (D / 64) * (2 * FF / 32), I_B = (FF / 64) * (D / 32), I_IN = (D / 64) * (1024 / 32), I_Z = (D / 32) * 8, I_O = (D / 64) * (D / 32);
    constexpr int NITEMS = 2 * I_A + 2 * I_B + I_IN + I_Z + I_O;
    for (int it = gw; it < NITEMS; it += NGW) {
        int r = it;
        if (r < I_Z) { p0_zfold_item(F.win, F.gmix, F.WIN, 32 * (r >> 3), r & 7, scr, F.lane); continue; } r -= I_Z;
        if (r < I_A) { const int nb = r % (2 * FF / 32), kb = r / (2 * FF / 32); p0_transpose_item(F.w1a, 2 * FF, w1a_srccol(32 * nb), D, F.W1A, 32 * nb, 64 * kb, F.g1, scr, F.lane); continue; } r -= I_A;
        if (r < I_A) { const int nb = r % (2 * FF / 32), kb = r / (2 * FF / 32); p0_transpose_item(F.w2a, 2 * FF, w1a_srccol(32 * nb), D, F.W2A, 32 * nb, 64 * kb, F.g2, scr, F.lane); continue; } r -= I_A;
        if (r < I_B) { const int nb = r % (D / 32), kb = r / (D / 32); p0_transpose_item(F.w1b, D, 32 * nb, FF, F.W1B, 32 * nb, 64 * kb, nullptr, scr, F.lane); continue; } r -= I_B;
        if (r < I_B) { const int nb = r % (D / 32), kb = r / (D / 32); p0_transpose_item(F.w2b, D, 32 * nb, FF, F.W2B, 32 * nb, 64 * kb, nullptr, scr, F.lane); continue; } r -= I_B;
        if (r < I_IN) { const int nb = r % (1024 / 32), kb = r / (1024 / 32); p0_transpose_item(F.win, NIN, 32 * nb, D, F.WIN, 32 * nb, 64 * kb, F.gmix, scr, F.lane); continue; } r -= I_IN;
        { const int nb = r % (D / 32), kb = r / (D / 32); const int k0 = 64 * kb; p0_transpose_item(F.wout, D, 32 * nb, D, F.WOUT, 32 * nb, k0, k0 < LW ? F.glru : F.gfour - LW, scr, F.lane); }
    }
    for (int m = gw; m < M + NMETA; m += NGW) { if (m < M) rms_row_to_bf16(F.x + (size_t)m * D, F.XN + (size_t)m * D, F.lane); else rms_row_to_bf16(F.meta + (size_t)(m - M) * D, F.XNM + (size_t)(m - M) * D, F.lane); }
    for (int i = gw * 64 + F.lane; i < NMETA * D; i += NGW * 64) F.H1ACC[i] = 0.f;
}

typedef float f32x4m __attribute__((ext_vector_type(4)));
__device__ __forceinline__ bf16x8 ld_frag(const bf16* p) { return *(const bf16x8*)p; }
__device__ __forceinline__ void meta_stage1(Frame& F, int ct) {
    const int fr = F.lane & 15, fq = F.lane >> 4, pn = ct >> 3, within = (ct & 7) * 16;
    const bf16* a = F.XNM + fr * D + 8 * fq; const bf16* bg = F.W1A + (size_t)(256 * pn + within + fr) * D + 8 * fq; const bf16* bu = bg + (size_t)128 * D;
    f32x4 ag = {0.f, 0.f, 0.f, 0.f}, au = {0.f, 0.f, 0.f, 0.f};
#pragma unroll 8
    for (int s = 0; s < D / 32; ++s) { const bf16x8 av = ld_frag(a + 32 * s); ag = __builtin_amdgcn_mfma_f32_16x16x32_bf16(av, ld_frag(bg + 32 * s), ag, 0, 0, 0); au = __builtin_amdgcn_mfma_f32_16x16x32_bf16(av, ld_frag(bu + 32 * s), au, 0, 0, 0); }
#pragma unroll
    for (int r = 0; r < 4; ++r) F.HBM[(4 * fq + r) * FF + 16 * ct + fr] = (bf16)f2bf(pg8::silu_mul(ag[r], au[r]));
}
__device__ __forceinline__ void meta_stage2(Frame& F, int piece) {
    const int fr = F.lane & 15, fq = F.lane >> 4, ct = piece & 63, ks = piece >> 6;
    const bf16* a = F.HBM + fr * FF + 128 * ks + 8 * fq; const bf16* b = F.W1B + (size_t)(16 * ct + fr) * FF + 128 * ks + 8 * fq;
    f32x4 acc = {0.f, 0.f, 0.f, 0.f};
#pragma unroll
    for (int s = 0; s < 4; ++s) acc = __builtin_amdgcn_mfma_f32_16x16x32_bf16(ld_frag(a + 32 * s), ld_frag(b + 32 * s), acc, 0, 0, 0);
#pragma unroll
    for (int r = 0; r < 4; ++r) atomicAdd(F.H1ACC + (4 * fq + r) * D + 16 * ct + fr, acc[r]);
}
__device__ __forceinline__ void meta_stage3(Frame& F, int ct) {
    const int fr = F.lane & 15, fq = F.lane >> 4;
    const float* pm = F.meta + fr * D + 8 * fq; const float* pa = F.H1ACC + fr * D + 8 * fq; const bf16* b = F.WIN + (size_t)(16 * ct + fr) * D + 8 * fq;
    float ss = 0.f;
    for (int s = 0; s < D / 32; ++s) {
#pragma unroll
        for (int j = 0; j < 8; ++j) { const float v = pm[32 * s + j] + 0.5f * __hip_atomic_load(pa + 32 * s + j, RLX_AGENT); ss += v * v; } }
    ss += __shfl_xor(ss, 16); ss += __shfl_xor(ss, 32);
    const float rstd = 1.f / sqrtf(ss * (1.f / D) + EPS);
    f32x4 acc = {0.f, 0.f, 0.f, 0.f};
    for (int s = 0; s < D / 32; ++s) { float v[8];
#pragma unroll
        for (int j = 0; j < 8; ++j) v[j] = (pm[32 * s + j] + 0.5f * __hip_atomic_load(pa + 32 * s + j, RLX_AGENT)) * rstd;
        v4u w; w.x = pk2(v[0], v[1]); w.y = pk2(v[2], v[3]); w.z = pk2(v[4], v[5]); w.w = pk2(v[6], v[7]);
        acc = __builtin_amdgcn_mfma_f32_16x16x32_bf16(__builtin_bit_cast(bf16x8, w), ld_frag(b + 32 * s), acc, 0, 0, 0); }
#pragma unroll
    for (int r = 0; r < 4; ++r) F.UM[(4 * fq + r) * NIN + 16 * ct + fr] = (bf16)f2bf(acc[r]);
}


typedef short s16x4 __attribute__((ext_vector_type(4)));
typedef short v4i16_t __attribute__((ext_vector_type(4)));
__device__ __forceinline__ s16x4 lds_tr(LAS unsigned char* p) { return __builtin_bit_cast(s16x4, __builtin_amdgcn_ds_read_tr16_b64_v4i16((LAS v4i16_t*)p)); }
__device__ __forceinline__ bf16x8 cat8(s16x4 a, s16x4 b) { bf16x8 r; r[0] = a[0]; r[1] = a[1]; r[2] = a[2]; r[3] = a[3]; r[4] = b[0]; r[5] = b[1]; r[6] = b[2]; r[7] = b[3]; return r; }
__device__ __forceinline__ void p0_tables(Frame& F) {
    const int gid = (F.vcu * NWAVES + F.wave) * 64 + F.lane, NT = F.G * NWAVES * 64;
    for (int i = gid; i < 288 * 288; i += NT) { const int mrow = i / 288, kk = i % 288, p = mrow >= 144, k1 = mrow - 144 * p, pp = kk >= 144, t1 = kk - 144 * pp, idx = (k1 * t1) % 144;
        const float c = cospif((float)idx * (1.0f / 72.0f)), s = sinpif((float)idx * (1.0f / 72.0f)); F.A1[i] = (bf16)f2bf(p == pp ? c : (p == 0 ? s : -s)); }
    for (int i = gid; i < 57 * 144; i += NT) { const int t2 = i / 144, k1 = i % 144; const float a = (2.0f * (float)(k1 * t2)) / (float)T; F.TW[2 * i] = cospif(a); F.TW[2 * i + 1] = sinpif(a); }
    for (int i = gid; i < 128 * 128; i += NT) { const int mrow = i >> 7, kk = i & 127, p = mrow >> 6, k2 = mrow & 63, pp = kk >> 6, t2 = kk & 63; float v = 0.f;
        if (k2 < 57 && t2 < 57) { const int idx = (k2 * t2) % 57; const float c = cospif((2.0f * (float)idx) / 57.0f), s = sinpif((2.0f * (float)idx) / 57.0f); v = p == pp ? c : (p == 0 ? s : -s); }
        F.A2[i] = (bf16)f2bf(v); }
    const float sc = 1.0f / sqrtf(64.0f * (float)T);
    for (int i = gid; i < 8 * 64 * 128; i += NT) { const int g = i >> 13, n = (i >> 7) & 63, kk = i & 127, seg = kk >> 5, m = kk & 31; const float* wf = F.fw + (size_t)g * 4096 + n; float v;
        if (seg == 0) v = m == 0 ? 0.5f * wf[0] : wf[m * 64];
        else if (seg == 2) v = m == 0 ? 0.5f * wf[0] : wf[(64 - m) * 64];
        else v = m == 0 ? 0.5f * wf[32 * 64] : 0.f;
        F.WF2[i] = (bf16)f2bf(v * sc); }
}
constexpr int P1 = 528, P2 = 1040;
__device__ __forceinline__ void fft1_item(Frame& F, int it) {
    const int hc = it & 1, t2 = (it >> 1) % 57, b = (it >> 1) / 57;
    LAS unsigned char* tile = F.lds + RING_OFF;
    for (int c = F.tid; c < 144 * 32; c += NWAVES * 64) { const int t1 = c >> 5, p = (c >> 4) & 1, cc = c & 15, t = 57 * t1 + t2;
        const bf16* src = (t < NMETA ? F.UM + t * NIN : F.U + (size_t)(b * SEQ + t - NMETA) * NIN) + 1024 + 256 * p + 128 * hc + 8 * cc;
        *(LAS v4u*)(tile + t1 * P1 + p * 256 + cc * 16) = *(const v4u*)src; }
    __syncthreads();
    const int w = F.wave, lane = F.lane, g = lane >> 4, fr = lane & 15, q = fr >> 2, p4 = lane & 3;
    bf16x8 Bf[9];
#pragma unroll
    for (int ks = 0; ks < 9; ++ks) { s16x4 h[2];
#pragma unroll
        for (int t = 0; t < 2; ++t) { const int kk0 = 32 * ks + 8 * g + 4 * t, pl = kk0 >= 144 ? 1 : 0, t1 = kk0 - 144 * pl + q; h[t] = lds_tr(tile + t1 * P1 + pl * 256 + (16 * w + 4 * p4) * 2); }
        Bf[ks] = cat8(h[0], h[1]); }
    __syncthreads();
    f32x4 acc[18];
#pragma unroll
    for (int mt = 0; mt < 18; ++mt) { acc[mt] = (f32x4){0.f, 0.f, 0.f, 0.f}; const bf16* ap = F.A1 + (16 * mt + fr) * 288 + 8 * g;
#pragma unroll
        for (int ks = 0; ks < 9; ++ks) acc[mt] = __builtin_amdgcn_mfma_f32_16x16x32_bf16(*(const bf16x8*)(ap + 32 * ks), Bf[ks], acc[mt], 0, 0, 0);
        if (mt & 1) asm volatile("" ::: "memory"); }
#pragma unroll
    for (int mt = 0; mt < 9; ++mt) { const int k1 = 16 * mt + 4 * g; const f32x4* twp = (const f32x4*)(F.TW + 2 * (t2 * 144 + k1)); const f32x4 ta = twp[0], tb = twp[1];
        const float cs[8] = {ta[0], ta[1], ta[2], ta[3], tb[0], tb[1], tb[2], tb[3]};
#pragma unroll
        for (int r = 0; r < 4; ++r) { const float c = cs[2 * r], s = cs[2 * r + 1], yr = acc[mt][r], yi = acc[mt + 9][r];
            LAS unsigned char* o = tile + (k1 + r) * P1 + (16 * w + fr) * 2;
            *(LAS bf16*)o = (bf16)f2bf(yr * c + yi * s); *(LAS bf16*)(o + 256) = (bf16)f2bf(yi * c - yr * s); } }
    __syncthreads();
    for (int c = F.tid; c < 144 * 32; c += NWAVES * 64) { const int k1 = c >> 5, p = (c >> 4) & 1, cc = c & 15;
        *(v4u*)(F.Y + ((size_t)(b * 144 + k1) * 57 + t2) * 512 + 256 * p + 128 * hc + 8 * cc) = *(LAS v4u*)(tile + k1 * P1 + p * 256 + cc * 16); }
    __syncthreads();
}
__device__ __forceinline__ void fft2_item(Frame& F, int it) {
    const int b = it / 144, k1 = it % 144;
    LAS unsigned char* tile = F.lds + RING_OFF;
    const bf16* ysrc = F.Y + (size_t)(b * 144 + k1) * 57 * 512;
    for (int c = F.tid; c < 64 * 64; c += NWAVES * 64) { const int t2 = c >> 6, cc = c & 63; v4u v = {0u, 0u, 0u, 0u}; if (t2 < 57) v = *(const v4u*)(ysrc + t2 * 512 + 8 * cc); *(LAS v4u*)(tile + t2 * P2 + cc * 16) = v; }
    __syncthreads();
    const int w = F.wave, lane = F.lane, g = lane >> 4, fr = lane & 15, q = fr >> 2, p4 = lane & 3;
    bf16x8 Bf[2][4];
#pragma unroll
    for (int nt = 0; nt < 2; ++nt)
#pragma unroll
        for (int ks = 0; ks < 4; ++ks) { s16x4 h[2];
#pragma unroll
            for (int t = 0; t < 2; ++t) { const int kk0 = 32 * ks + 8 * g + 4 * t, pl = kk0 >> 6, t2 = (kk0 & 63) + q; h[t] = lds_tr(tile + t2 * P2 + pl * 512 + (32 * w + 16 * nt + 4 * p4) * 2); }
            Bf[nt][ks] = cat8(h[0], h[1]); }
    __syncthreads();
    f32x4 acc[8][2];
#pragma unroll
    for (int mt = 0; mt < 8; ++mt) { acc[mt][0] = (f32x4){0.f, 0.f, 0.f, 0.f}; acc[mt][1] = (f32x4){0.f, 0.f, 0.f, 0.f}; const bf16* ap = F.A2 + (16 * mt + fr) * 128 + 8 * g;
#pragma unroll
        for (int ks = 0; ks < 4; ++ks) { const bf16x8 a = *(const bf16x8*)(ap + 32 * ks);
            acc[mt][0] = __builtin_amdgcn_mfma_f32_16x16x32_bf16(a, Bf[0][ks], acc[mt][0], 0, 0, 0); acc[mt][1] = __builtin_amdgcn_mfma_f32_16x16x32_bf16(a, Bf[1][ks], acc[mt][1], 0, 0, 0); }
        if (mt & 1) asm volatile("" ::: "memory"); }
#pragma unroll
    for (int mt = 0; mt < 8; ++mt) { const int p = mt >> 2, k2b = 16 * (mt & 3) + 4 * g;
#pragma unroll
        for (int r = 0; r < 4; ++r) if (k2b + r < 57) {
#pragma unroll
            for (int nt = 0; nt < 2; ++nt) *(LAS bf16*)(tile + (k2b + r) * P2 + p * 512 + (32 * w + 16 * nt + fr) * 2) = (bf16)f2bf(acc[mt][nt][r]); } }
    __syncthreads();
    for (int c = F.tid; c < 57 * 64; c += NWAVES * 64) { const int k2 = c >> 6, cc = c & 63; *(v4u*)(F.GB + ((size_t)b * T + k1 + 144 * k2) * 512 + 8 * cc) = *(LAS v4u*)(tile + k2 * P2 + cc * 16); }
    __syncthreads();
}
__device__ __forceinline__ void ffin_item(Frame& F, int it) {
    const int b = it >> 7, j0 = 64 * (it & 127);
    LAS unsigned char* tile = F.lds + RING_OFF; LAS float* part = (LAS float*)(F.lds + RING_OFF + 68 * 1024); LAS float* rs = part + 512;
    const int w = F.wave, lane = F.lane, fq = lane >> 4, fr = lane & 15;
    bf16x8 Bf[4][4];
#pragma unroll
    for (int nt = 0; nt < 4; ++nt)
#pragma unroll
        for (int ks = 0; ks < 4; ++ks) Bf[nt][ks] = *(const bf16x8*)(F.WF2 + (size_t)((w * 64 + 16 * nt + fr) * 128 + 32 * ks + 8 * fq));
    f32x4 acc[4][4];
#pragma unroll
    for (int mt = 0; mt < 4; ++mt) { const int k = NMETA + j0 + 16 * mt + fr, kp = T - k; const bf16* gk = F.GB + ((size_t)b * T + k) * 512 + 32 * w + 8 * fq; const bf16* gm = F.GB + ((size_t)b * T + kp) * 512 + 32 * w + 8 * fq;
        const bf16x8 a0 = *(const bf16x8*)gk, a1 = *(const bf16x8*)(gk + 256), a2 = *(const bf16x8*)gm, a3 = *(const bf16x8*)(gm + 256);
#pragma unroll
        for (int nt = 0; nt < 4; ++nt) { f32x4 c = {0.f, 0.f, 0.f, 0.f};
            c = __builtin_amdgcn_mfma_f32_16x16x32_bf16(a0, Bf[nt][0], c, 0, 0, 0); c = __builtin_amdgcn_mfma_f32_16x16x32_bf16(a1, Bf[nt][1], c, 0, 0, 0);
            c = __builtin_amdgcn_mfma_f32_16x16x32_bf16(a2, Bf[nt][2], c, 0, 0, 0); c = __builtin_amdgcn_mfma_f32_16x16x32_bf16(a3, Bf[nt][3], c, 0, 0, 0); acc[mt][nt] = c; }
        asm volatile("" ::: "memory"); }
    float bv[4];
#pragma unroll
    for (int nt = 0; nt < 4; ++nt) bv[nt] = F.fb[64 * w + 16 * nt + fr];
#pragma unroll
    for (int mt = 0; mt < 4; ++mt)
#pragma unroll
        for (int r = 0; r < 4; ++r) { float ss = 0.f;
#pragma unroll
            for (int nt = 0; nt < 4; ++nt) { acc[mt][nt][r] += bv[nt]; ss += acc[mt][nt][r] * acc[mt][nt][r]; }
            ss += __shfl_xor(ss, 1); ss += __shfl_xor(ss, 2); ss += __shfl_xor(ss, 4); ss += __shfl_xor(ss, 8);
            if (fr == 0) part[w * 64 + 16 * mt + 4 * fq + r] = ss; }
    __syncthreads();
    if (F.tid < 64) { float s = 0.f;
#pragma unroll
        for (int ww = 0; ww < 8; ++ww) s += part[ww * 64 + F.tid];
        rs[F.tid] = 1.0f / sqrtf(s * (1.0f / LW) + EPS); }
    __syncthreads();
#pragma unroll
    for (int mt = 0; mt < 4; ++mt)
#pragma unroll
        for (int r = 0; r < 4; ++r) { const int row = 16 * mt + 4 * fq + r; const float rr = rs[row];
#pragma unroll
            for (int nt = 0; nt < 4; ++nt) *(LAS bf16*)(tile + row * P2 + (64 * w + 16 * nt + fr) * 2) = (bf16)f2bf(acc[mt][nt][r] * rr); }
    __syncthreads();
    for (int c = F.tid; c < 64 * 64; c += NWAVES * 64) { const int row = c >> 6, cc = c & 63; *(v4u*)(F.YB + (size_t)(b * SEQ + j0 + row) * D + 512 + 8 * cc) = *(LAS v4u*)(tile + row * P2 + cc * 16); }
    __syncthreads();
}


__device__ __forceinline__ float lru_x_at(const bf16* U, const bf16* UM, int b, int t, int C) {
    if (t < 0 || t >= T) return 0.f;
    return bf2f(t < NMETA ? UM[t * NIN + C] : U[(size_t)(b * SEQ + t - NMETA) * NIN + C]);
}
constexpr int NCH = 257, SCAN_WAVE_BYTES = 17408, SCAN_PART_OFF = 8 * SCAN_WAVE_BYTES;
__device__ __forceinline__ float sigmoid_fast(float x) { return __builtin_amdgcn_rcpf(1.0f + __builtin_amdgcn_exp2f(x * -1.44269504089f)); }
__device__ __forceinline__ float em1_poly(float x) { return x * (1.0f + x * (0.5f + x * ((1.0f / 6.0f) + x * ((1.0f / 24.0f) + x * ((1.0f / 120.0f) + x * (1.0f / 720.0f)))))); }
__device__ __forceinline__ void p0_gate_weights(Frame& F) {
    const int gid = (F.vcu * NWAVES + F.wave) * 64 + F.lane, NT = F.G * NWAVES * 64;
    const float* w00 = F.waf; const float* w01 = F.wxf; const float* w10 = F.wab; const float* w11 = F.wxb;
    for (int i = gid; i < 8 * 64 * 64; i += NT) { const int k = i & 63, n = (i >> 6) & 63, h = i >> 12; const int s = (h * 64 + k) * 64 + n, d = h * 16384 + n * 64 + k;
        F.WG[d] = (bf16)f2bf(w00[s]); F.WG[d + 4096] = (bf16)f2bf(w01[s]); F.WG[d + 8192] = (bf16)f2bf(w10[s]); F.WG[d + 12288] = (bf16)f2bf(w11[s]); }
}
template <int PASS, int DIR, int MT> __device__ __forceinline__ void scan_mt(Frame& F, int b, int t0, int C, int lane, int fr, int fq, LAS float* xcf, LAS float* pre, const bf16x8 (&Bf)[2][4][2],
                                                                          float ba, float bx, float c8, float (&hy)[32], float& hst, float& pp) {
    bf16x8 a[2];
#pragma unroll
    for (int ks = 0; ks < 2; ++ks) { const LAS f32x4* p = (const LAS f32x4*)(xcf + (16 * MT + fr) * 68 + 32 * ks + 8 * fq); const f32x4 u = p[0], v = p[1];
        v4u w; w.x = pg8::cvt_pk_bf16(u[0], u[1]); w.y = pg8::cvt_pk_bf16(u[2], u[3]); w.z = pg8::cvt_pk_bf16(v[0], v[1]); w.w = pg8::cvt_pk_bf16(v[2], v[3]); a[ks] = __builtin_bit_cast(bf16x8, w); }
#pragma unroll
    for (int wh = 0; wh < 2; ++wh)
#pragma unroll
        for (int nt = 0; nt < 4; ++nt) { f32x4 acc = {0.f, 0.f, 0.f, 0.f};
            acc = __builtin_amdgcn_mfma_f32_16x16x32_bf16(a[0], Bf[wh][nt][0], acc, 0, 0, 0); acc = __builtin_amdgcn_mfma_f32_16x16x32_bf16(a[1], Bf[wh][nt][1], acc, 0, 0, 0);
#pragma unroll
            for (int r = 0; r < 4; ++r) pre[(wh * 16 + 4 * fq + r) * 68 + 16 * nt + fr] = acc[r]; }
    LDS_WAIT(); asm volatile("" ::: "memory");
    float gt[16];
    if (PASS == 2 && DIR == 1) {
#pragma unroll
        for (int i = 0; i < 16; ++i) gt[i] = bf2f(F.U[(size_t)(b * SEQ + t0 - NMETA + 16 * MT + i) * NIN + 512 + C]); }
#pragma unroll
    for (int ii = 0; ii < 16; ++ii) { const int i = DIR ? 15 - ii : ii; const int row = 16 * MT + i;
        const float rp = pre[i * 68 + lane] + ba, ip = pre[(16 + i) * 68 + lane] + bx, xcr = xcf[row * 68 + lane];
        const float r = sigmoid_fast(rp), ig = sigmoid_fast(ip), la = c8 * r, la2 = la + la;
        const float av = __builtin_amdgcn_exp2f(la * 1.44269504089f);
        const float m2 = la2 > -0.3f ? -em1_poly(la2) : 1.0f - av * av;
        hst = av * hst + __builtin_amdgcn_sqrtf(m2) * (ig * xcr); pp *= av;
        if (PASS == 2) { if (DIR == 0) hy[row] = hst; else { const float g = gt[i]; const float z = 1.5957691216057308f * (g + 0.044715f * g * g * g); hy[row] = (hy[row] + hst) * g * sigmoid_fast(z); } }
        if ((ii & 3) == 3) asm volatile("" ::: "memory"); }
    LDS_WAIT(); asm volatile("" ::: "memory");
}
template <int PASS, int DIR> __device__ __forceinline__ void scan_dir(Frame& F, int b, int c, int t0, bool ismeta, int h, int C, int lane, int fr, int fq, LAS float* xcf, LAS float* pre, float (&hy)[32]) {
    const float* lamp = DIR ? F.lamb : F.lamf; const float ba = (DIR ? F.bab : F.baf)[C], bx = (DIR ? F.bxb : F.bxf)[C];
    const float c8 = -8.0f * log1pf(expf(-lamp[C]));
    bf16x8 Bf[2][4][2];
#pragma unroll
    for (int wh = 0; wh < 2; ++wh)
#pragma unroll
        for (int nt = 0; nt < 4; ++nt)
#pragma unroll
            for (int ks = 0; ks < 2; ++ks) Bf[wh][nt][ks] = *(const bf16x8*)(F.WG + (size_t)((((h * 2 + DIR) * 2 + wh) * 64 + 16 * nt + fr) * 64 + 32 * ks + 8 * fq));
    float hst = 0.f, pp = 1.0f;
    if (PASS == 2) hst = F.CAR[(size_t)((b * 2 + DIR) * NCH + c) * LW + C];
    if (DIR == 0) { scan_mt<PASS, 0, 0>(F, b, t0, C, lane, fr, fq, xcf, pre, Bf, ba, bx, c8, hy, hst, pp); if (!ismeta) scan_mt<PASS, 0, 1>(F, b, t0, C, lane, fr, fq, xcf, pre, Bf, ba, bx, c8, hy, hst, pp); }
    else          { if (!ismeta) scan_mt<PASS, 1, 1>(F, b, t0, C, lane, fr, fq, xcf, pre, Bf, ba, bx, c8, hy, hst, pp); scan_mt<PASS, 1, 0>(F, b, t0, C, lane, fr, fq, xcf, pre, Bf, ba, bx, c8, hy, hst, pp); }
    if (PASS == 1) { typedef float f32x2v __attribute__((ext_vector_type(2))); *(f32x2v*)(F.SUM + ((size_t)((b * 2 + DIR) * NCH + c) * LW + C) * 2) = (f32x2v){pp, hst}; }
}
template <int PASS> __device__ __forceinline__ void scan_item(Frame& F, int b, int c) {
    int opq = 0; asm volatile("" : "+v"(opq));
    const int h = F.wave, lane = F.lane + opq, C = 64 * h + lane, fr = lane & 15, fq = lane >> 4;
    LAS float* xcf = (LAS float*)(F.lds + RING_OFF + h * SCAN_WAVE_BYTES);
    LAS float* pre = xcf + 32 * 68;
    const bool ismeta = (c == 0); const int t0 = ismeta ? 0 : NMETA + 32 * (c - 1);
    { float x[35];
#pragma unroll
      for (int i = 0; i < 35; ++i) x[i] = lru_x_at(F.U, F.UM, b, t0 - 2 + i, C);
      const float cw0 = F.convw[C], cw1 = F.convw[LW + C], cw2 = F.convw[2 * LW + C], cw3 = F.convw[3 * LW + C], cb = F.convb[C];
#pragma unroll
      for (int r = 0; r < 32; ++r) xcf[r * 68 + lane] = cb + cw0 * x[r] + cw1 * x[r + 1] + cw2 * x[r + 2] + cw3 * x[r + 3]; }
    LDS_WAIT(); asm volatile("" ::: "memory");
    float hy[32];
    scan_dir<PASS, 0>(F, b, c, t0, ismeta, h, C, lane, fr, fq, xcf, pre, hy);
    asm volatile("" ::: "memory");
    if (PASS == 2 || !ismeta) scan_dir<PASS, 1>(F, b, c, t0, ismeta, h, C, lane, fr, fq, xcf, pre, hy);
    if (PASS == 2) {
        LAS float* sq = pre;
        LAS float* part = (LAS float*)(F.lds + RING_OFF + SCAN_PART_OFF); LAS float* rs = part + 256;
#pragma unroll
        for (int r = 0; r < 32; ++r) sq[r * 65 + lane] = hy[r] * hy[r];
        LDS_WAIT(); asm volatile("" ::: "memory");
        { const int rr = lane & 31, hh = lane >> 5; float s = 0.f;
#pragma unroll
          for (int j = 0; j < 32; ++j) s += sq[rr * 65 + 32 * hh + j];
          s += __shfl_xor(s, 32); if (lane < 32) part[h * 32 + lane] = s; }
        __syncthreads();
        if (F.tid < 32) { float s = 0.f;
#pragma unroll
            for (int w = 0; w < 8; ++w) s += part[w * 32 + F.tid];
            rs[F.tid] = 1.0f / sqrtf(s * (1.0f / LW) + EPS); }
        __syncthreads();
        bf16* dst = F.YB + (size_t)(b * SEQ + t0 - NMETA) * D + C;
#pragma unroll
        for (int r = 0; r < 32; ++r) dst[(size_t)r * D] = (bf16)f2bf(hy[r] * rs[r]);
        __syncthreads();
    }
}
__device__ __forceinline__ void carry_scan_block(Frame& F, int blk) {
    typedef float f32x2v __attribute__((ext_vector_type(2)));
    const int h = blk & 7, dir = (blk >> 3) & 1, b = blk >> 4, w = F.wave, lane = F.lane, C = 64 * h + lane;
    LAS f32x2v* comp = (LAS f32x2v*)(F.lds + RING_OFF);
    const size_t base = (size_t)((b * 2 + dir) * NCH) * LW + C;
    f32x2v ps[33];
#pragma unroll
    for (int j = 0; j < 33; ++j) { const int o = 33 * w + j; ps[j] = (f32x2v){1.0f, 0.0f}; if (o < NCH) { const int c = dir ? NCH - 1 - o : o; ps[j] = *(const f32x2v*)(F.SUM + (base + (size_t)c * LW) * 2); } }
    float P = 1.0f, S = 0.0f;
#pragma unroll
    for (int j = 0; j < 33; ++j) { S = ps[j].x * S + ps[j].y; P *= ps[j].x; }
    comp[w * 64 + lane] = (f32x2v){P, S};
    __syncthreads();
    float cin = 0.0f;
    for (int ww = 0; ww < w; ++ww) { const f32x2v q = comp[ww * 64 + lane]; cin = q.x * cin + q.y; }
#pragma unroll
    for (int j = 0; j < 33; ++j) { const int o = 33 * w + j; if (o < NCH) { const int c = dir ? NCH - 1 - o : o; F.CAR[base + (size_t)c * LW] = cin; cin = ps[j].x * cin + ps[j].y; } }
    __syncthreads();
}

__device__ __forceinline__ float gelu_tanh(float x) {
    const float z = 1.5957691216057308f * (x + 0.044715f * x * x * x);
    return x / (1.0f + expf(-z));
}
__device__ __forceinline__ void final_norm(Frame& F) {
    const int gw = F.vcu * NWAVES + F.wave, NGW = F.G * NWAVES, lane = F.lane;
    for (int row = gw; row < M; row += NGW) {
        const float rstd = pg8::row_rstd(F.SL3, row);
        GAS f32x4* p = (GAS f32x4*)(F.out + (size_t)row * D) + lane; const GAS f32x4* gp = (const GAS f32x4*)F.gfin + lane;
#pragma unroll
        for (int j = 0; j < 4; ++j) { const f32x4 v = p[64 * j], g = gp[64 * j]; p[64 * j] = v * rstd * g; }
    }
}

struct Args { const float* in[28]; float* out; unsigned char* ws; int ph_lo, ph_hi, li, pad; };
__global__ void __launch_bounds__(NWAVES * 64, 2) fwd_kernel(Args args) {
    extern __shared__ __attribute__((aligned(16))) unsigned char lds[];
    Frame F;
    F.lds = (LAS unsigned char*)lds;
    F.MISC = (volatile LAS unsigned*)(F.lds + MISC_OFF);
    F.tid = threadIdx.x; F.lane = F.tid & 63; F.wave = __builtin_amdgcn_readfirstlane(F.tid >> 6);
    F.G = gridDim.x; F.bx = blockIdx.x; { const int bx = blockIdx.x; F.vcu = (F.G % 8 == 0) ? (bx % 8) * (F.G / 8) + bx / 8 : bx; }
#define GRID_BAR() do { if (N_LAUNCHES == 1) xcd_barrier(bar); } while (0)
    unsigned char* ws = args.ws;
    F.ctl = (gu32*)(ws + WS_CTL);
    F.x = args.in[0]; F.meta = args.in[1]; F.g1 = args.in[2]; F.w1a = args.in[3]; F.w1b = args.in[4]; F.gmix = args.in[5]; F.win = args.in[6]; F.convw = args.in[7]; F.convb = args.in[8];
    F.waf = args.in[9]; F.baf = args.in[10]; F.wxf = args.in[11]; F.bxf = args.in[12]; F.lamf = args.in[13]; F.wab = args.in[14]; F.bab = args.in[15]; F.wxb = args.in[16]; F.bxb = args.in[17]; F.lamb = args.in[18];
    F.fw = args.in[19]; F.fb = args.in[20]; F.glru = args.in[21]; F.gfour = args.in[22]; F.wout = args.in[23]; F.g2 = args.in[24]; F.w2a = args.in[25]; F.w2b = args.in[26]; F.gfin = args.in[27]; F.out = args.out;
    F.W1A = (bf16*)(ws + WS_W1A); F.W1B = (bf16*)(ws + WS_W1B); F.WIN = (bf16*)(ws + WS_WIN); F.WOUT = (bf16*)(ws + WS_WOUT); F.W2A = (bf16*)(ws + WS_W2A); F.W2B = (bf16*)(ws + WS_W2B);
    F.XN = (bf16*)(ws + WS_XN); F.HB = (bf16*)(ws + WS_HB); F.H1B = (bf16*)(ws + WS_H1B); F.U = (bf16*)(ws + WS_U); F.YB = (bf16*)(ws + WS_YB); F.H2B = (bf16*)(ws + WS_H1B);
    F.XNM = (bf16*)(ws + WS_XNM); F.HBM = (bf16*)(ws + WS_HBM); F.UM = (bf16*)(ws + WS_UM); F.H1ACC = (float*)(ws + WS_H1ACC);
    F.SL1 = (float*)(ws + WS_SL1); F.SL2 = (float*)(ws + WS_SL2); F.SL3 = (float*)(ws + WS_SL3);
    F.A1 = (bf16*)(ws + WS_A1); F.A2 = (bf16*)(ws + WS_A2); F.WF2 = (bf16*)(ws + WS_WF2); F.TW = (float*)(ws + WS_TW); F.Y = (bf16*)(ws + WS_Y); F.GB = (bf16*)(ws + WS_G);
    F.WG = (bf16*)(ws + WS_WG); F.SUM = (float*)(ws + WS_SUM); F.CAR = (float*)(ws + WS_CAR);
    for (int u = F.tid; u < (LDS_BYTES - LDSCTL_OFF) / 4; u += NWAVES * 64) ((LAS unsigned*)(F.lds + LDSCTL_OFF))[u] = 0u;
    __syncthreads();
    XcdBarrier bar; bar.bar = (unsigned*)(F.ctl + CW_BAR); bar.x = 0; bar.st = nullptr;
    if (N_LAUNCHES == 1) bar = xcd_barrier_post((unsigned*)(F.ctl + CW_BAR), F.MISC + 8);
    const int lo = args.ph_lo, hi = args.ph_hi;
#define IN(k) (lo <= (k) && (k) < hi)
    const int slack = ((int)blockIdx.x - 128) * NWAVES + F.wave;

    if (IN(0)) { p0_prologue(F); p0_tables(F); p0_gate_weights(F); GRID_BAR(); }
    if (IN(1)) {
        if (slack >= 0 && slack < FF / 16) meta_stage1(F, slack);
        pg8::Gemm g{F.XN, F.W1A, M, 2 * FF, D}; pg8::StaticOrder S; S.init(M, 2 * FF, F.G, (int)blockIdx.x);
        pg8::EpiSwiglu E{F.HB, FF, nullptr};
        pg8::gemm_phase<pg8::EpiSwiglu, pg8::StaticOrder, PG8_ALIGN, PG8_SP2>(F.lds + RING_OFF, g, S, E);
        GRID_BAR();
    }
    if (IN(2)) {
        { const int piece = (int)blockIdx.x * NWAVES + F.wave; if (piece < 64 * (FF / 128)) meta_stage2(F, piece); }
        pg8::Gemm g{F.HB, F.W1B, M, D, FF}; pg8::StaticOrder S; S.init(M, D, F.G, (int)blockIdx.x);
        pg8::EpiResid E{F.x, F.out, F.H1B, F.SL1, 0.5f, D};
        pg8::gemm_phase<pg8::EpiResid, pg8::StaticOrder, false, PG8_SP2>(F.lds + RING_OFF, g, S, E);
        GRID_BAR();
    }
    if (IN(3)) {
        if (slack >= 0 && slack < NIN / 16) meta_stage3(F, slack);
        pg8::Gemm g{F.H1B, F.WIN, M, NIN, D}; pg8::StaticOrder S; S.init(M, NIN, F.G, (int)blockIdx.x);
        pg8::EpiScaleBf16 E{F.U, NIN, F.SL1};
        pg8::gemm_phase<pg8::EpiScaleBf16, pg8::StaticOrder, PG8_ALIGN, PG8_SP2>(F.lds + RING_OFF, g, S, E);
        GRID_BAR();
    }
    if (IN(4)) {
        for (int it = (int)blockIdx.x; it < 2 * NCH; it += F.G) scan_item<1>(F, it / NCH, it % NCH);
        __syncthreads();
        for (int it = (int)blockIdx.x; it < 2 * 57 * 2; it += F.G) fft1_item(F, it);
        GRID_BAR();
    }
    if (IN(5)) {
        if (blockIdx.x >= F.G - 32) carry_scan_block(F, (int)blockIdx.x - (F.G - 32));
        for (int it = (int)blockIdx.x; it < 2 * 144; it += F.G) fft2_item(F, it);
        GRID_BAR();
    }
    if (IN(6)) {
        for (int it = (int)blockIdx.x; it < 2 * (NCH - 1); it += F.G) scan_item<2>(F, it / (NCH - 1), 1 + it % (NCH - 1));
        for (int it = (int)blockIdx.x; it < 256; it += F.G) ffin_item(F, it);
        GRID_BAR();
    }
    if (IN(7)) {
        pg8::Gemm g{F.YB, F.WOUT, M, D, D}; pg8::StaticOrder S; S.init(M, D, F.G, (int)blockIdx.x);
        pg8::EpiResid E{F.out, F.out, F.H2B, F.SL2, 1.0f, D};
        pg8::gemm_phase<pg8::EpiResid, pg8::StaticOrder, false, PG8_SP2>(F.lds + RING_OFF, g, S, E);
        GRID_BAR();
    }
    if (IN(8)) {
        pg8::Gemm g{F.H2B, F.W2A, M, 2 * FF, D}; pg8::StaticOrder S; S.init(M, 2 * FF, F.G, (int)blockIdx.x);
        pg8::EpiSwiglu E{F.HB, FF, F.SL2};
        pg8::gemm_phase<pg8::EpiSwiglu, pg8::StaticOrder, PG8_ALIGN, PG8_SP2>(F.lds + RING_OFF, g, S, E);
        GRID_BAR();
    }
    if (IN(9)) {
        pg8::Gemm g{F.HB, F.W2B, M, D, FF}; pg8::StaticOrder S; S.init(M, D, F.G, (int)blockIdx.x);
        pg8::EpiResid E{F.out, F.out, nullptr, F.SL3, 0.5f, D};
        pg8::gemm_phase<pg8::EpiResid, pg8::StaticOrder, false, PG8_SP2>(F.lds + RING_OFF, g, S, E);
        GRID_BAR();
    }
    if (IN(10)) { final_norm(F); }
#undef IN
}

extern "C" void kernel_launch(void* const* d_in, const int* in_sizes, int n_in, void* d_out, int out_size, void* d_ws, size_t ws_size, hipStream_t stream) {
    static int grid = 0;
    if (grid == 0) {
        if (n_in != 28 || out_size != M * D || ws_size < WS_END) { fprintf(stderr, "kernel_launch: unexpected shapes: n_in %d out %d ws %zu\n", n_in, out_size, ws_size); grid = -1; return; }
        int dev = 0, cus = 0;
        if (hipGetDevice(&dev) != hipSuccess || hipDeviceGetAttribute(&cus, hipDeviceAttributeMultiprocessorCount, dev) != hipSuccess) { grid = -1; return; }
        if (hipFuncSetAttribute((const void*)fwd_kernel, hipFuncAttributeMaxDynamicSharedMemorySize, LDS_BYTES) != hipSuccess) { fprintf(stderr, "kernel_launch: hipFuncSetAttribute failed\n"); grid = -1; return; }
        int per_cu = 0;
        if (hipOccupancyMaxActiveBlocksPerMultiprocessor(&per_cu, (const void*)fwd_kernel, NWAVES * 64, LDS_BYTES) != hipSuccess || per_cu < 1) fprintf(stderr, "kernel_launch: occupancy query reports %d\n", per_cu);
        (void)hipGetLastError();
        grid = cus;
        if (grid != 256) fprintf(stderr, "kernel_launch: %d CUs (built for 256)\n", grid);
    }
    if (grid < 0) return;
    if (hipMemsetAsync((char*)d_ws + WS_CTL, 0, CTL_ZERO_BYTES, stream) != hipSuccess) return;
    Args a{};
    for (int i = 0; i < 28; ++i) a.in[i] = (const float*)d_in[i];
    a.out = (float*)d_out; a.ws = (unsigned char*)d_ws;
    if (N_LAUNCHES == 1) { a.ph_lo = 0; a.ph_hi = NPH; a.li = 0; hipLaunchKernelGGL(fwd_kernel, dim3(grid), dim3(NWAVES * 64), LDS_BYTES, stream, a); }
    else for (int li = 0; li < NPH; ++li) { a.ph_lo = li; a.ph_hi = li + 1; a.li = li; hipLaunchKernelGGL(fwd_kernel, dim3(grid), dim3(NWAVES * 64), LDS_BYTES, stream, a); }
}
```

```cpp
#include <hip/hip_runtime.h>
#include <cstdio>
#include <cstdint>
#include <cmath>
namespace pg8 {
#define PG8_LAS __attribute__((address_space(3)))
typedef unsigned short bf16_t;
typedef short bf16x8 __attribute__((ext_vector_type(8)));
typedef float f32x4 __attribute__((ext_vector_type(4)));
typedef unsigned u32x4 __attribute__((ext_vector_type(4)));
constexpr int BM = 256, BK = 64, HALF = 128, HTB = HALF * BK * 2  , STAGE_BYTES = 8 * HTB, NXCD = 8, WGM = 8;

__host__ __device__ __forceinline__ int lds_byte(int r, int c) { const int st = (r >> 4) * 2 + (c >> 5), rr = r & 15, cc = c & 31, ob = rr * 64 + cc * 2; return st * 1024 + (ob ^ (((ob >> 9) & 1) << 5)); }
__host__ __device__ __forceinline__ void stage_rc(int b, int& R, int& C) { const int st = b / 1024, sb = b % 1024, swz = sb ^ (((sb >> 9) & 1) << 5); R = (st >> 1) * 16 + swz / 64; C = (st & 1) * 32 + (swz % 64) / 2; }
__host__ __device__ __forceinline__ int perm32(int rho) { const int n = rho >> 4, i = rho & 15; return 8 * (i >> 2) + 4 * n + (i & 3); }

struct Unit { int pm, pn; };
struct Gemm { const bf16_t* A; const bf16_t* Bt; int M, N, K; };

struct StaticOrder {
    int nM, nN, nwg, G, c;
    __host__ __device__ void init(int M, int N, int G_, int c_) { nM = M / BM; nN = N / BM; nwg = nM * nN; G = G_; c = c_; }
    __host__ __device__ bool next(int i, Unit& u) const {
        const long L = (long)i * G + c; if (L >= nwg) return false;
        int wgid = (int)L; { const int q = nwg / NXCD, r = nwg % NXCD, xcd = wgid % NXCD, off = wgid / NXCD; wgid = (xcd < r ? xcd * (q + 1) : r * (q + 1) + (xcd - r) * q) + off; }
        const int nig = WGM * nN, gid = wgid / nig, fm = gid * WGM, gsz = (nM - fm) < WGM ? (nM - fm) : WGM;
        u.pm = fm + ((wgid % nig) % gsz); u.pn = (wgid % nig) / gsz; return true;
    }
    __device__ __forceinline__ void a_ready(const Unit&) const {}
    __device__ __forceinline__ void done(const Unit&) const {}
};

__device__ __forceinline__ unsigned cvt_pk_bf16(float lo, float hi) { unsigned r; asm volatile("v_cvt_pk_bf16_f32 %0, %1, %2" : "=v"(r) : "v"(lo), "v"(hi)); return r; }
typedef unsigned u32x2 __attribute__((ext_vector_type(2)));
constexpr float RMS_EPS = 1e-6f;
__device__ __forceinline__ float row_rstd(const float* slots, int r) {
    const f32x4* p = (const f32x4*)(slots + (size_t)r * 16);
    const f32x4 a = p[0], b = p[1], c = p[2], d = p[3];
    const float s = (((a[0] + a[1]) + (a[2] + a[3])) + ((b[0] + b[1]) + (b[2] + b[3]))) + (((c[0] + c[1]) + (c[2] + c[3])) + ((d[0] + d[1]) + (d[2] + d[3])));
    return 1.0f / sqrtf(s * (1.0f / 1024.0f) + RMS_EPS);
}
__device__ __forceinline__ float silu_mul(float g, float u) {
    const float e = __builtin_amdgcn_exp2f(g * -1.44269504089f);
    return g * __builtin_amdgcn_rcpf(1.0f + e) * u;
}
struct EpiSwiglu {
    static constexpr bool PERM = true, AFTER_DRAIN = false;
    bf16_t* O; int ldc; const float* slots;
    __device__ __forceinline__ void operator()(const f32x4 (&acc)[2][2][4][2], const Unit& u, int wr, int wc, int fr, int fq) const {
        const int row0 = u.pm * BM + wr * 64 + fr, col0 = u.pn * HALF + wc * 32 + 8 * fq;
#pragma unroll
        for (int ai = 0; ai < 2; ++ai)
#pragma unroll
            for (int m = 0; m < 4; ++m) { const int r = row0 + ai * HALF + m * 16; const float s = slots ? row_rstd(slots, r) : 1.0f;
                const f32x4 g0 = acc[ai][0][m][0] * s, g1 = acc[ai][0][m][1] * s, u0 = acc[ai][1][m][0] * s, u1 = acc[ai][1][m][1] * s;
                u32x4 w; w.x = cvt_pk_bf16(silu_mul(g0[0], u0[0]), silu_mul(g0[1], u0[1])); w.y = cvt_pk_bf16(silu_mul(g0[2], u0[2]), silu_mul(g0[3], u0[3]));
                w.z = cvt_pk_bf16(silu_mul(g1[0], u1[0]), silu_mul(g1[1], u1[1])); w.w = cvt_pk_bf16(silu_mul(g1[2], u1[2]), silu_mul(g1[3], u1[3]));
                *(u32x4*)(O + (size_t)r * ldc + col0) = w; }
    }
};
struct EpiScaleBf16 {
    static constexpr bool PERM = true, AFTER_DRAIN = false;
    bf16_t* O; int ldc; const float* slots;
    __device__ __forceinline__ void operator()(const f32x4 (&acc)[2][2][4][2], const Unit& u, int wr, int wc, int fr, int fq) const {
        const int row0 = u.pm * BM + wr * 64 + fr, col0 = u.pn * BM + wc * 32 + 8 * fq;
#pragma unroll
        for (int ai = 0; ai < 2; ++ai)
#pragma unroll
            for (int m = 0; m < 4; ++m) { const int r = row0 + ai * HALF + m * 16; const float s = row_rstd(slots, r); bf16_t* rowp = O + (size_t)r * ldc + col0;
#pragma unroll
                for (int bj = 0; bj < 2; ++bj) { const f32x4 v0 = acc[ai][bj][m][0] * s, v1 = acc[ai][bj][m][1] * s;
                    u32x4 w; w.x = cvt_pk_bf16(v0[0], v0[1]); w.y = cvt_pk_bf16(v0[2], v0[3]); w.z = cvt_pk_bf16(v1[0], v1[1]); w.w = cvt_pk_bf16(v1[2], v1[3]);
                    *(u32x4*)(rowp + bj * HALF) = w; } }
    }
};
struct EpiResid {
    static constexpr bool PERM = false, AFTER_DRAIN = false;
    const float* base; float* out; bf16_t* ob; float* slots; float alpha; int ldc;
    __device__ __forceinline__ void operator()(const f32x4 (&acc)[2][2][4][2], const Unit& u, int wr, int wc, int fr, int fq) const {
        const int row0 = u.pm * BM + wr * 64 + fr, col0 = u.pn * BM + wc * 32 + 4 * fq;
#pragma unroll
        for (int ai = 0; ai < 2; ++ai)
#pragma unroll
            for (int m = 0; m < 4; ++m) { const int r = row0 + ai * HALF + m * 16; const size_t off = (size_t)r * ldc + col0; float ss = 0.f;
#pragma unroll
                for (int bj = 0; bj < 2; ++bj)
#pragma unroll
                    for (int n = 0; n < 2; ++n) { const size_t o = off + bj * HALF + n * 16; const f32x4 b = *(const f32x4*)(base + o); const f32x4 v = b + acc[ai][bj][m][n] * alpha;
                        *(f32x4*)(out + o) = v; ss += (v[0] * v[0] + v[1] * v[1]) + (v[2] * v[2] + v[3] * v[3]);
                        if (ob) { u32x2 w; w.x = cvt_pk_bf16(v[0], v[1]); w.y = cvt_pk_bf16(v[2], v[3]); *(u32x2*)(ob + o) = w; } }
                ss += __shfl_xor(ss, 16); ss += __shfl_xor(ss, 32);
                if (fq == 0) slots[(size_t)r * 16 + u.pn * 4 + wc] = ss; }
    }
};

template <class Epi, class Sched, bool ALIGN_EPI = false, bool SP2 = false>
__device__ __forceinline__ void gemm_phase(PG8_LAS unsigned char* lds, const Gemm g, const Sched& S, const Epi& E) {
    const int tid = threadIdx.x, wid = __builtin_amdgcn_readfirstlane(tid >> 6), lane = tid & 63, wr = wid >> 2, wc = wid & 3, fr = lane & 15, fq = lane >> 4;
    const int K = g.K, nt = K / BK;
    unsigned voffA[2], voffB[2];
#pragma unroll
    for (int i = 0; i < 2; ++i) { int R, C; stage_rc(tid * 16 + i * 8192, R, C); const int Rb = Epi::PERM ? ((R & ~31) + perm32(R & 31)) : R;
        voffA[i] = (unsigned)(R * K + C) * 2u; voffB[i] = (unsigned)(Rb * K + C) * 2u; }
    const size_t kstep = (size_t)(BK * 2);
    const size_t hstep = (size_t)HALF * K * 2;
    const size_t tstep = 2 * hstep;
    const unsigned ldsw = (unsigned)wid * 1024u;
    const int aoff = lds_byte(wr * 64 + fr, fq * 8), boff = lds_byte(wc * 32 + fr, fq * 8);
#define PG8_SA(b, h) (((b) * 2 + (h)) * HTB)
#define PG8_SB(b, h) ((4 + (b) * 2 + (h)) * HTB)
#define PG8_STAGE(bufoff, gbase, voff) do { _Pragma("unroll") for (int _i = 0; _i < 2; ++_i) \
        __builtin_amdgcn_global_load_lds((const unsigned*)((const char*)(gbase) + (voff)[_i]), (PG8_LAS unsigned*)(lds + (bufoff) + ldsw + _i * 8192), 16, 0, 0); } while (0)
#define PG8_LDA(dst, b, h) do { _Pragma("unroll") for (int m = 0; m < 4; ++m) _Pragma("unroll") for (int k = 0; k < 2; ++k) dst[m][k] = *(const PG8_LAS bf16x8*)(lds + PG8_SA(b, h) + aoff + m * 2048 + k * 1024); } while (0)
#define PG8_LDB(dst, b, h) do { _Pragma("unroll") for (int n = 0; n < 2; ++n) _Pragma("unroll") for (int k = 0; k < 2; ++k) dst[n][k] = *(const PG8_LAS bf16x8*)(lds + PG8_SB(b, h) + boff + n * 2048 + k * 1024); } while (0)
#define PG8_MMA(ai, bj, At, Bt) do { __builtin_amdgcn_s_setprio(1); _Pragma("unroll") for (int m = 0; m < 4; ++m) _Pragma("unroll") for (int n = 0; n < 2; ++n) _Pragma("unroll") for (int k = 0; k < 2; ++k) \
        acc[ai][bj][m][n] = __builtin_amdgcn_mfma_f32_16x16x32_bf16(Bt[n][k], At[m][k], acc[ai][bj][m][n], 0, 0, 0); __builtin_amdgcn_s_setprio(0); } while (0)
#define PG8_WAIT_V(n) asm volatile("s_waitcnt vmcnt(" #n ")" ::: "memory")
#define PG8_WAIT_L(n) asm volatile("s_waitcnt lgkmcnt(" #n ")" ::: "memory")
#define PG8_BAR __builtin_amdgcn_s_barrier()
#define PG8_SCHED __builtin_amdgcn_sched_barrier(0)
    Unit cur, nxt; int ui = 0;
    if (!S.next(0, cur)) return;
    f32x4 acc[2][2][4][2];
#pragma unroll
    for (int a = 0; a < 2; ++a)
#pragma unroll
        for (int b = 0; b < 2; ++b)
#pragma unroll
            for (int m = 0; m < 4; ++m)
#pragma unroll
                for (int n = 0; n < 2; ++n) acc[a][b][m][n] = (f32x4){0.f, 0.f, 0.f, 0.f};
    bf16x8 At[4][2], B0[2][2], B1[2][2];
    const char* cA = (const char*)g.A + (size_t)cur.pm * tstep; const char* cB = (const char*)g.Bt + (size_t)cur.pn * tstep;
    S.a_ready(cur);
    if constexpr (SP2) {
        PG8_STAGE(PG8_SB(0, 0), cB, voffB); PG8_STAGE(PG8_SB(0, 1), cB + hstep, voffB); PG8_STAGE(PG8_SA(0, 0), cA, voffA); PG8_STAGE(PG8_SA(0, 1), cA + hstep, voffA);
        if (wr == 1) PG8_BAR;
        PG8_WAIT_V(2); PG8_BAR;
        PG8_STAGE(PG8_SB(1, 0), cB + kstep, voffB); PG8_STAGE(PG8_SA(1, 0), cA + kstep, voffA); PG8_STAGE(PG8_SB(1, 1), cB + hstep + kstep, voffB);
        PG8_WAIT_V(6); PG8_BAR;
    } else {
        PG8_STAGE(PG8_SB(0, 0), cB, voffB); PG8_STAGE(PG8_SA(0, 0), cA, voffA); PG8_STAGE(PG8_SB(0, 1), cB + hstep, voffB); PG8_STAGE(PG8_SA(0, 1), cA + hstep, voffA);
        if (wr == 1) PG8_BAR;
        PG8_WAIT_V(4); PG8_BAR;
        PG8_STAGE(PG8_SB(1, 0), cB + kstep, voffB); PG8_STAGE(PG8_SA(1, 0), cA + kstep, voffA); PG8_STAGE(PG8_SB(1, 1), cB + hstep + kstep, voffB);
        PG8_WAIT_V(6); PG8_BAR;
    }
    for (;;) {
        const bool has_next = S.next(ui + 1, nxt);
        const char* nA = has_next ? (const char*)g.A + (size_t)nxt.pm * tstep : cA; const char* nB = has_next ? (const char*)g.Bt + (size_t)nxt.pn * tstep : cB;
        for (int t = 0; t < nt; t += 2) {
            const bool last = (t == nt - 2);
            const char* a1 = cA + (size_t)(t + 1) * kstep;
            const char* a2 = last ? nA : cA + (size_t)(t + 2) * kstep; const char* b2 = last ? nB : cB + (size_t)(t + 2) * kstep;
            const char* a3 = a2 + kstep; const char* b3 = b2 + kstep;
            if (last && has_next) S.a_ready(nxt);
            if constexpr (SP2) {
            PG8_LDB(B0, 0, 0); PG8_LDB(B1, 0, 1); PG8_SCHED; PG8_LDA(At, 0, 0); PG8_STAGE(PG8_SA(1, 1), a1 + hstep, voffA);
            PG8_WAIT_V(8); PG8_WAIT_L(0); PG8_BAR; PG8_MMA(0, 0, At, B0); PG8_MMA(0, 1, At, B1); PG8_BAR; PG8_SCHED;
            PG8_LDA(At, 0, 1); PG8_STAGE(PG8_SB(0, 0), b2, voffB); PG8_STAGE(PG8_SB(0, 1), b2 + hstep, voffB); PG8_STAGE(PG8_SA(0, 0), a2, voffA);
            PG8_WAIT_V(8); PG8_WAIT_L(0); PG8_BAR; PG8_MMA(1, 0, At, B0); PG8_MMA(1, 1, At, B1); PG8_BAR; PG8_SCHED;
            PG8_LDB(B0, 1, 0); PG8_LDB(B1, 1, 1); PG8_SCHED; PG8_LDA(At, 1, 0); PG8_STAGE(PG8_SA(0, 1), a2 + hstep, voffA);
            PG8_WAIT_V(8); PG8_WAIT_L(0); PG8_BAR; PG8_MMA(0, 0, At, B0); PG8_MMA(0, 1, At, B1); PG8_BAR; PG8_SCHED;
            PG8_LDA(At, 1, 1); PG8_STAGE(PG8_SB(1, 0), b3, voffB); PG8_STAGE(PG8_SB(1, 1), b3 + hstep, voffB); PG8_STAGE(PG8_SA(1, 0), a3, voffA);
            PG8_WAIT_V(8); PG8_WAIT_L(0); PG8_BAR; PG8_MMA(1, 0, At, B0); PG8_MMA(1, 1, At, B1); PG8_BAR; PG8_SCHED;
            } else {
            PG8_LDB(B0, 0, 0); PG8_SCHED; PG8_LDA(At, 0, 0); PG8_STAGE(PG8_SA(1, 1), a1 + hstep, voffA);
            PG8_WAIT_L(8); PG8_BAR; PG8_WAIT_L(0); PG8_MMA(0, 0, At, B0); PG8_BAR; PG8_SCHED;
            PG8_LDB(B1, 0, 1); PG8_STAGE(PG8_SB(0, 0), b2, voffB);
            PG8_BAR; PG8_WAIT_L(0); PG8_MMA(0, 1, At, B1); PG8_BAR;
            PG8_LDA(At, 0, 1); PG8_STAGE(PG8_SA(0, 0), a2, voffA);
            PG8_BAR; PG8_WAIT_L(0); PG8_MMA(1, 0, At, B0); PG8_BAR; PG8_SCHED;
            PG8_STAGE(PG8_SB(0, 1), b2 + hstep, voffB);
            PG8_WAIT_V(6); PG8_BAR; PG8_MMA(1, 1, At, B1); PG8_BAR;
            PG8_LDB(B0, 1, 0); PG8_SCHED; PG8_LDA(At, 1, 0); PG8_STAGE(PG8_SA(0, 1), a2 + hstep, voffA);
            PG8_WAIT_L(8); PG8_BAR; PG8_WAIT_L(0); PG8_MMA(0, 0, At, B0); PG8_BAR; PG8_SCHED;
            PG8_LDB(B1, 1, 1); PG8_STAGE(PG8_SB(1, 0), b3, voffB);
            PG8_BAR; PG8_WAIT_L(0); PG8_MMA(0, 1, At, B1); PG8_BAR;
            PG8_LDA(At, 1, 1); PG8_STAGE(PG8_SA(1, 0), a3, voffA);
            PG8_BAR; PG8_WAIT_L(0); PG8_MMA(1, 0, At, B0); PG8_BAR; PG8_SCHED;
            PG8_STAGE(PG8_SB(1, 1), b3 + hstep, voffB);
            PG8_WAIT_V(6); PG8_BAR; PG8_MMA(1, 1, At, B1); PG8_BAR;
            }
        }
        if constexpr (ALIGN_EPI) { if (wr == 0) PG8_BAR; }
        if constexpr (!Epi::AFTER_DRAIN) { E(acc, cur, wr, wc, fr, fq); S.done(cur); }
        if (!has_next) break;
#pragma unroll
        for (int a = 0; a < 2; ++a)
#pragma unroll
            for (int b = 0; b < 2; ++b)
#pragma unroll
                for (int m = 0; m < 4; ++m)
#pragma unroll
                    for (int n = 0; n < 2; ++n) acc[a][b][m][n] = (f32x4){0.f, 0.f, 0.f, 0.f};
        cur = nxt; cA = nA; cB = nB; ++ui;
        if constexpr (ALIGN_EPI) { if (wr == 1) PG8_BAR; }
    }
    PG8_WAIT_V(0);
    if constexpr (!ALIGN_EPI) { if (wr == 0) PG8_BAR; }
    PG8_BAR;
    if constexpr (Epi::AFTER_DRAIN) { E.fused(acc, cur, wr, wc, fr, fq, lds, wid, lane); S.done(cur); }
#undef PG8_SA
#undef PG8_SB
#undef PG8_STAGE
#undef PG8_LDA
#undef PG8_LDB
#undef PG8_MMA
#undef PG8_WAIT_V
#undef PG8_WAIT_L
#undef PG8_BAR
#undef PG8_SCHED
}
}
#ifndef PG8_SP2
#define PG8_SP2 true
#endif
#ifndef PG8_ALIGN
#define PG8_ALIGN true
#endif
constexpr int NWAVES = 8;
#ifndef MK_N_LAUNCHES
#define MK_N_LAUNCHES 1
#endif
constexpr int NPH = 11;
constexpr int N_LAUNCHES = MK_N_LAUNCHES;

constexpr int BATCH = 2, SEQ = 8192, NMETA = 16, T = SEQ + NMETA, D = 1024, FF = 2816, NIN = 1536, LW = 512, NH = 8, HD = 64;
constexpr int M = BATCH * SEQ;
constexpr float EPS = 1e-6f;

constexpr size_t MiB = 1u << 20, KiB = 1u << 10;
constexpr size_t WS_CTL = 0, CTL_ZERO_BYTES = 1 * MiB;
constexpr size_t WS_XNM = 1 * MiB, WS_HBM = WS_XNM + 64 * KiB, WS_H1ACC = WS_XNM + 192 * KiB, WS_UM = WS_XNM + 256 * KiB;
constexpr size_t WS_SL1 = 2 * MiB, WS_SL2 = 3 * MiB, WS_SL3 = 4 * MiB;
constexpr size_t WS_W1A = 8 * MiB, WS_W1B = WS_W1A + 11 * MiB, WS_WIN = WS_W1B + 11 * MiB / 2, WS_WOUT = WS_WIN + 3 * MiB, WS_W2A = WS_WOUT + 2 * MiB, WS_W2B = WS_W2A + 11 * MiB, WS_WEND = WS_W2B + 11 * MiB / 2;
constexpr size_t WS_HB = 48 * MiB;
constexpr size_t WS_XN = 136 * MiB;
constexpr size_t WS_H1B = 168 * MiB;
constexpr size_t WS_U = 48 * MiB;
constexpr size_t WS_WG = 6 * MiB, WS_CAR = WS_WG + 512 * KiB;
constexpr size_t WS_SUM = 96 * MiB;
constexpr size_t WS_G = 162 * MiB;
constexpr size_t WS_Y = 232 * MiB;
constexpr size_t WS_A1 = 5 * MiB, WS_TW = WS_A1 + 192 * KiB, WS_A2 = WS_A1 + 320 * KiB, WS_WF2 = WS_A1 + 384 * KiB;
constexpr size_t WS_YB = 200 * MiB;
constexpr size_t WS_END = 256 * MiB;
static_assert(WS_WEND <= WS_HB && WS_G + (size_t)2 * T * 512 * 4 <= WS_YB && WS_YB + (size_t)M * D * 2 <= WS_END, "d_ws map");
constexpr int CW_TMO = 0, CW_CODE = 1, CW_BAR = 4096;

constexpr int RING_OFF = 0, RING_BYTES = 131072;
constexpr int LDSCTL_OFF = 146432, MISC_OFF = LDSCTL_OFF + 320;
constexpr int LDS_BYTES = 147456;

#define GAS __attribute__((address_space(1)))
#define LAS __attribute__((address_space(3)))
typedef unsigned short bf16;
typedef unsigned v4u __attribute__((ext_vector_type(4)));
typedef float f32x4 __attribute__((ext_vector_type(4)));
typedef short bf16x8 __attribute__((ext_vector_type(8)));
typedef GAS unsigned gu32;
#define RLX_AGENT __ATOMIC_RELAXED, __HIP_MEMORY_SCOPE_AGENT
#define LDS_WAIT() asm volatile("s_waitcnt lgkmcnt(0)" ::: "memory")
#define VM_WAIT() asm volatile("s_waitcnt vmcnt(0)" ::: "memory")
__device__ __forceinline__ unsigned f2bf(float f) { unsigned u = __builtin_bit_cast(unsigned, f); return (u + 0x7fffu + ((u >> 16) & 1u)) >> 16; }
__device__ __forceinline__ unsigned pk2(float lo, float hi) { return f2bf(lo) | (f2bf(hi) << 16); }
__device__ __forceinline__ float bf2f(unsigned short b) { return __builtin_bit_cast(float, (unsigned)b << 16); }
__device__ __forceinline__ float wave_sum(float v) {
#pragma unroll
    for (int o = 1; o < 64; o <<= 1) v += __shfl_xor(v, o);
    return v;
}

#define XB_TMO      128
#define XB_XCNT(j)  (256  + 64 * (j))
#define XB_XSUB(j)  (1280 + 64 * (j))
#define XB_XGEN(j)  (2304 + 64 * (j))
#define XB_TOP      3328
#define XB_TOPGEN   3392
#define XCD_BAR_WORDS 3456
#define XB_SPIN_CAP (1u << 18)

__device__ __forceinline__ unsigned xb_ld(unsigned* p)              { return __hip_atomic_load(p, __ATOMIC_RELAXED, __HIP_MEMORY_SCOPE_AGENT); }
__device__ __forceinline__ unsigned xb_add(unsigned* p, unsigned v) { return __hip_atomic_fetch_add(p, v, __ATOMIC_RELAXED, __HIP_MEMORY_SCOPE_AGENT); }
__device__ __forceinline__ unsigned xb_xcc_id() { return (unsigned)__builtin_amdgcn_s_getreg((3 << 11) | 20) & 0xFu; }
#define XB_SPIN(cond, bar) do { unsigned _sp = 0; while (cond) { __builtin_amdgcn_s_sleep(1); \
    if ((++_sp & 255u) == 0u) { if (xb_ld(&(bar)[XB_TMO])) break; if (_sp > XB_SPIN_CAP) { atomicAdd(&(bar)[XB_TMO], 1u); break; } } } } while (0)

struct XcdBarrier {
    unsigned* bar; unsigned x;
    volatile LAS unsigned* st;
};

__device__ __forceinline__ XcdBarrier xcd_barrier_post(unsigned* bar, volatile LAS unsigned* st) {
    XcdBarrier b; b.bar = bar; b.x = xb_xcc_id(); b.st = st;
    if (threadIdx.x == 0) (void)xb_add(&bar[XB_XCNT(b.x)], 1u);
    return b;
}
__device__ __forceinline__ void xcd_barrier_complete(unsigned* bar, unsigned x, unsigned& nloc, unsigned& nx) {
    const unsigned G = gridDim.x * gridDim.y * gridDim.z;
    unsigned sum, cnt, mine, sp = 0u;
    for (;;) {
        sum = 0u; cnt = 0u; mine = 0u;
#pragma unroll
        for (unsigned j = 0; j < 16; ++j) { const unsigned c = xb_ld(&bar[XB_XCNT(j)]); sum += c; cnt += (c > 0u) ? 1u : 0u; mine = (j == x) ? c : mine; }
        if (sum == G) break;
        __builtin_amdgcn_s_sleep(1);
        if ((++sp & 255u) == 0u) { if (xb_ld(&bar[XB_TMO])) break; if (sp > XB_SPIN_CAP) { atomicAdd(&bar[XB_TMO], 1u); break; } }
    }
    nloc = mine > 0u ? mine : 1u; nx = cnt > 0u ? cnt : 1u;
}

__device__ __forceinline__ void xcd_barrier(const XcdBarrier& b) {
    asm volatile("s_waitcnt vmcnt(0)" ::: "memory");
    __syncthreads();
    if (threadIdx.x == 0) {
        unsigned* bar = b.bar;
        __builtin_amdgcn_s_waitcnt(0);
        unsigned nloc = b.st[0], nx = b.st[1];
        if (nloc == 0u) { xcd_barrier_complete(bar, b.x, nloc, nx); b.st[0] = nloc; b.st[1] = nx; }
        const unsigned old = xb_add(&bar[XB_XSUB(b.x)], 1u);
        const unsigned gen = old / nloc;
        if (old + 1u == (gen + 1u) * nloc) {
            __builtin_amdgcn_fence(__ATOMIC_RELEASE, "agent");
            asm volatile("s_waitcnt vmcnt(0)" ::: "memory");
            const unsigned og = xb_add(&bar[XB_TOP], 1u);
            const unsigned tg = og / nx;
            if (og + 1u == (tg + 1u) * nx) xb_add(&bar[XB_TOPGEN], 1u);
            else XB_SPIN(xb_ld(&bar[XB_TOPGEN]) == tg, bar);
            __builtin_amdgcn_fence(__ATOMIC_ACQUIRE, "agent");
            xb_add(&bar[XB_XGEN(b.x)], 1u);
            asm volatile("s_waitcnt vmcnt(0)" ::: "memory");
        } else {
            XB_SPIN(xb_ld(&bar[XB_XGEN(b.x)]) == gen, bar);
            __builtin_amdgcn_fence(__ATOMIC_ACQUIRE, "agent");
            asm volatile("s_waitcnt vmcnt(0)" ::: "memory");
        }
    }
    __syncthreads();
}
struct Frame {
    LAS unsigned char* lds;
    volatile LAS unsigned* MISC;
    gu32* ctl;
    int tid, lane, wave;
    int vcu, G, bx;
    const float* x; const float* meta; float* out;
    const float *g1, *w1a, *w1b, *gmix, *win, *convw, *convb, *waf, *baf, *wxf, *bxf, *lamf, *wab, *bab, *wxb, *bxb, *lamb, *fw, *fb, *glru, *gfour, *wout, *g2, *w2a, *w2b, *gfin;
    bf16 *W1A, *W1B, *WIN, *WOUT, *W2A, *W2B;
    bf16 *XN, *HB, *H1B, *U, *YB, *H2B, *XNM, *HBM, *UM;
    float *H1ACC, *SL1, *SL2, *SL3;
    bf16 *A1, *A2, *WF2, *Y, *GB, *WG; float *TW, *SUM, *CAR;
};

__device__ __forceinline__ void p0_transpose_item(const float* W, int ldw, int srcc0, int K, bf16* WT, int dstr0, int k0, const float* ksc, LAS float* scr, int lane) {
    float v[32];
#pragma unroll
    for (int i = 0; i < 32; ++i) v[i] = W[(size_t)(k0 + 2 * i + (lane >> 5)) * ldw + srcc0 + (lane & 31)];
    const int c = lane & 7;
    f32x4 s0 = {1.f, 1.f, 1.f, 1.f}, s1 = {1.f, 1.f, 1.f, 1.f};
    if (ksc) { s0 = *(const f32x4*)(ksc + k0 + 8 * c); s1 = *(const f32x4*)(ksc + k0 + 8 * c + 4); }
#pragma unroll
    for (int i = 0; i < 32; ++i) scr[(2 * i + (lane >> 5)) * 33 + (lane & 31)] = v[i];
    LDS_WAIT(); asm volatile("" ::: "memory");
#pragma unroll
    for (int j = 0; j < 4; ++j) { const int n = (lane >> 3) + 8 * j; const LAS float* s = scr + (8 * c) * 33 + n;
        v4u o; o.x = pk2(s[0 * 33] * s0[0], s[1 * 33] * s0[1]); o.y = pk2(s[2 * 33] * s0[2], s[3 * 33] * s0[3]); o.z = pk2(s[4 * 33] * s1[0], s[5 * 33] * s1[1]); o.w = pk2(s[6 * 33] * s1[2], s[7 * 33] * s1[3]);
        *(GAS v4u*)(WT + (size_t)(dstr0 + n) * K + k0 + 8 * c) = o; }
    LDS_WAIT(); asm volatile("" ::: "memory");
}
__device__ __forceinline__ void p0_zfold_item(const float* Win, const float* gmix, bf16* WT, int k0, int g, LAS float* scr, int lane) {
    LAS float* tab = scr + 32 * 65;
    tab[lane] = cospif((float)lane * (1.0f / 32.0f));
#pragma unroll 8
    for (int i = 0; i < 32; ++i) scr[i * 65 + lane] = Win[(size_t)(k0 + i) * NIN + 1024 + 64 * g + lane];
    LDS_WAIT(); asm volatile("" ::: "memory");
    const int k = lane & 31, half = lane >> 5;
    float xv[64];
#pragma unroll
    for (int c = 0; c < 64; ++c) xv[c] = scr[k * 65 + c];
    const float gk = gmix[k0 + k];
    for (int j = 0; j < 32; ++j) {
        const int jm = (half && j == 0) ? 32 : j, sh = (half && j > 0) ? 16 : 0; const float sg = (half && j > 0) ? -1.0f : 1.0f;
        float acc = 0.f;
#pragma unroll
        for (int c = 0; c < 64; ++c) acc += xv[c] * tab[(jm * c - sh) & 63];
        WT[(size_t)(1024 + 256 * half + 32 * g + j) * D + k0 + k] = (bf16)f2bf(acc * sg * gk);
    }
    LDS_WAIT(); asm volatile("" ::: "memory");
}
__device__ __forceinline__ void rms_row_to_bf16(const float* xrow, bf16* orow, int lane) {
    const GAS f32x4* xr = (const GAS f32x4*)xrow + lane;
    f32x4 v[4]; float s = 0.f;
#pragma unroll
    for (int j = 0; j < 4; ++j) { v[j] = xr[64 * j]; s += (v[j].x * v[j].x + v[j].y * v[j].y) + (v[j].z * v[j].z + v[j].w * v[j].w); }
    const float rstd = 1.f / sqrtf(wave_sum(s) * (1.f / D) + EPS);
    GAS unsigned long long* o8 = (GAS unsigned long long*)orow + lane;
#pragma unroll
    for (int j = 0; j < 4; ++j) o8[64 * j] = (unsigned long long)pk2(v[j].x * rstd, v[j].y * rstd) | ((unsigned long long)pk2(v[j].z * rstd, v[j].w * rstd) << 32);
}
__device__ __forceinline__ void rms_row2_to_bf16(const float* xa, bf16* oa, const float* xb, bf16* ob, int lane) {
    const GAS f32x4* pa = (const GAS f32x4*)xa + lane; const GAS f32x4* pb = (const GAS f32x4*)xb + lane;
    f32x4 va[4], vb[4]; float sa = 0.f, sb = 0.f;
#pragma unroll
    for (int j = 0; j < 4; ++j) { va[j] = pa[64 * j]; vb[j] = pb[64 * j]; }
#pragma unroll
    for (int j = 0; j < 4; ++j) { sa += (va[j].x * va[j].x + va[j].y * va[j].y) + (va[j].z * va[j].z + va[j].w * va[j].w); sb += (vb[j].x * vb[j].x + vb[j].y * vb[j].y) + (vb[j].z * vb[j].z + vb[j].w * vb[j].w); }
    const float ra = 1.f / sqrtf(wave_sum(sa) * (1.f / D) + EPS), rb = 1.f / sqrtf(wave_sum(sb) * (1.f / D) + EPS);
    GAS unsigned long long* qa = (GAS unsigned long long*)oa + lane; GAS unsigned long long* qb = (GAS unsigned long long*)ob + lane;
#pragma unroll
    for (int j = 0; j < 4; ++j) { qa[64 * j] = (unsigned long long)pk2(va[j].x * ra, va[j].y * ra) | ((unsigned long long)pk2(va[j].z * ra, va[j].w * ra) << 32);
        qb[64 * j] = (unsigned long long)pk2(vb[j].x * rb, vb[j].y * rb) | ((unsigned long long)pk2(vb[j].z * rb, vb[j].w * rb) << 32); }
}
__device__ __forceinline__ int w1a_srccol(int n0) { const int pn = n0 >> 8, r = n0 & 255; return r < 128 ? 128 * pn + r : FF + 128 * pn + (r - 128); }
__device__ __forceinline__ void p0_prologue(Frame& F) {
    LAS float* scr = (LAS float*)(F.lds + RING_OFF + F.wave * 16384);
    const int gw = F.vcu * NWAVES + F.wave, NGW = F.G * NWAVES;
    constexpr int I_A = (D / 64) * (2 * FF / 32), I_B = (FF / 64) * (D / 32), I_IN = (D / 64) * (1024 / 32), I_Z = (D / 32) * 8, I_O = (D / 64) * (D / 32);
    constexpr int NITEMS = 2 * I_A + 2 * I_B + I_IN + I_O;
    static_assert(I_Z == 256, "one Fourier-fold item per workgroup");
    if (F.wave == 0) for (int z = F.vcu; z < I_Z; z += F.G) p0_zfold_item(F.win, F.gmix, F.WIN, 32 * (z >> 3), z & 7, scr, F.lane);
    for (int it = gw; it < NITEMS; it += NGW) {
        int r = it;
        if (r < I_A) { const int nb = r % (2 * FF / 32), kb = r / (2 * FF / 32); p0_transpose_item(F.w1a, 2 * FF, w1a_srccol(32 * nb), D, F.W1A, 32 * nb, 64 * kb, F.g1, scr, F.lane); continue; } r -= I_A;
        if (r < I_A) { const int nb = r % (2 * FF / 32), kb = r / (2 * FF / 32); p0_transpose_item(F.w2a, 2 * FF, w1a_srccol(32 * nb), D, F.W2A, 32 * nb, 64 * kb, F.g2, scr, F.lane); continue; } r -= I_A;
        if (r < I_B) { const int nb = r % (D / 32), kb = r / (D / 32); p0_transpose_item(F.w1b, D, 32 * nb, FF, F.W1B, 32 * nb, 64 * kb, nullptr, scr, F.lane); continue; } r -= I_B;
        if (r < I_B) { const int nb = r % (D / 32), kb = r / (D / 32); p0_transpose_item(F.w2b, D, 32 * nb, FF, F.W2B, 32 * nb, 64 * kb, nullptr, scr, F.lane); continue; } r -= I_B;
        if (r < I_IN) { const int nb = r % (1024 / 32), kb = r / (1024 / 32); p0_transpose_item(F.win, NIN, 32 * nb, D, F.WIN, 32 * nb, 64 * kb, F.gmix, scr, F.lane); continue; } r -= I_IN;
        { const int nb = r % (D / 32), kb = r / (D / 32); const int k0 = 64 * kb; p0_transpose_item(F.wout, D, 32 * nb, D, F.WOUT, 32 * nb, k0, k0 < LW ? F.glru : F.gfour - LW, scr, F.lane); }
    }
    for (int m = gw; m < M; m += 2 * NGW) { const int m2 = m + NGW; rms_row2_to_bf16(F.x + (size_t)m * D, F.XN + (size_t)m * D, F.x + (size_t)m2 * D, F.XN + (size_t)m2 * D, F.lane); }
    if (gw < NMETA) rms_row_to_bf16(F.meta + (size_t)gw * D, F.XNM + (size_t)gw * D, F.lane);
    for (int i = gw * 64 + F.lane; i < NMETA * D; i += NGW * 64) F.H1ACC[i] = 0.f;
}

typedef float f32x4m __attribute__((ext_vector_type(4)));
__device__ __forceinline__ bf16x8 ld_frag(const bf16* p) { return *(const bf16x8*)p; }
__device__ __forceinline__ void meta_stage1(Frame& F, int ct) {
    const int fr = F.lane & 15, fq = F.lane >> 4, pn = ct >> 3, within = (ct & 7) * 16;
    const bf16* a = F.XNM + fr * D + 8 * fq; const bf16* bg = F.W1A + (size_t)(256 * pn + within + fr) * D + 8 * fq; const bf16* bu = bg + (size_t)128 * D;
    f32x4 ag = {0.f, 0.f, 0.f, 0.f}, au = {0.f, 0.f, 0.f, 0.f};
#pragma unroll 8
    for (int s = 0; s < D / 32; ++s) { const bf16x8 av = ld_frag(a + 32 * s); ag = __builtin_amdgcn_mfma_f32_16x16x32_bf16(av, ld_frag(bg + 32 * s), ag, 0, 0, 0); au = __builtin_amdgcn_mfma_f32_16x16x32_bf16(av, ld_frag(bu + 32 * s), au, 0, 0, 0); }
#pragma unroll
    for (int r = 0; r < 4; ++r) F.HBM[(4 * fq + r) * FF + 16 * ct + fr] = (bf16)f2bf(pg8::silu_mul(ag[r], au[r]));
}
__device__ __forceinline__ void meta_stage2(Frame& F, int piece) {
    const int fr = F.lane & 15, fq = F.lane >> 4, ct = piece & 63, ks = piece >> 6;
    const bf16* a = F.HBM + fr * FF + 128 * ks + 8 * fq; const bf16* b = F.W1B + (size_t)(16 * ct + fr) * FF + 128 * ks + 8 * fq;
    f32x4 acc = {0.f, 0.f, 0.f, 0.f};
#pragma unroll
    for (int s = 0; s < 4; ++s) acc = __builtin_amdgcn_mfma_f32_16x16x32_bf16(ld_frag(a + 32 * s), ld_frag(b + 32 * s), acc, 0, 0, 0);
#pragma unroll
    for (int r = 0; r < 4; ++r) atomicAdd(F.H1ACC + (4 * fq + r) * D + 16 * ct + fr, acc[r]);
}
__device__ __forceinline__ void meta_stage3(Frame& F, int ct) {
    const int fr = F.lane & 15, fq = F.lane >> 4;
    const float* pm = F.meta + fr * D + 8 * fq; const float* pa = F.H1ACC + fr * D + 8 * fq; const bf16* b = F.WIN + (size_t)(16 * ct + fr) * D + 8 * fq;
    float ss = 0.f;
    for (int s = 0; s < D / 32; ++s) {
#pragma unroll
        for (int j = 0; j < 8; ++j) { const float v = pm[32 * s + j] + 0.5f * __hip_atomic_load(pa + 32 * s + j, RLX_AGENT); ss += v * v; } }
    ss += __shfl_xor(ss, 16); ss += __shfl_xor(ss, 32);
    const float rstd = 1.f / sqrtf(ss * (1.f / D) + EPS);
    f32x4 acc = {0.f, 0.f, 0.f, 0.f};
    for (int s = 0; s < D / 32; ++s) { float v[8];
#pragma unroll
        for (int j = 0; j < 8; ++j) v[j] = (pm[32 * s + j] + 0.5f * __hip_atomic_load(pa + 32 * s + j, RLX_AGENT)) * rstd;
        v4u w; w.x = pk2(v[0], v[1]); w.y = pk2(v[2], v[3]); w.z = pk2(v[4], v[5]); w.w = pk2(v[6], v[7]);
        acc = __builtin_amdgcn_mfma_f32_16x16x32_bf16(__builtin_bit_cast(bf16x8, w), ld_frag(b + 32 * s), acc, 0, 0, 0); }
#pragma unroll
    for (int r = 0; r < 4; ++r) F.UM[(4 * fq + r) * NIN + 16 * ct + fr] = (bf16)f2bf(acc[r]);
}


typedef short s16x4 __attribute__((ext_vector_type(4)));
typedef short v4i16_t __attribute__((ext_vector_type(4)));
__device__ __forceinline__ s16x4 lds_tr(LAS unsigned char* p) { return __builtin_bit_cast(s16x4, __builtin_amdgcn_ds_read_tr16_b64_v4i16((LAS v4i16_t*)p)); }
__device__ __forceinline__ bf16x8 cat8(s16x4 a, s16x4 b) { bf16x8 r; r[0] = a[0]; r[1] = a[1]; r[2] = a[2]; r[3] = a[3]; r[4] = b[0]; r[5] = b[1]; r[6] = b[2]; r[7] = b[3]; return r; }
__device__ __forceinline__ void p0_tables(Frame& F) {
    const int gid = (F.vcu * NWAVES + F.wave) * 64 + F.lane, NT = F.G * NWAVES * 64;
    for (int i = gid; i < 288 * 288; i += NT) { const int mrow = i / 288, kk = i % 288, p = mrow >= 144, k1 = mrow - 144 * p, pp = kk >= 144, t1 = kk - 144 * pp, idx = (k1 * t1) % 144;
        const float c = cospif((float)idx * (1.0f / 72.0f)), s = sinpif((float)idx * (1.0f / 72.0f)); F.A1[i] = (bf16)f2bf(p == pp ? c : (p == 0 ? s : -s)); }
    for (int i = gid; i < 57 * 144; i += NT) { const int t2 = i / 144, k1 = i % 144; const float a = (2.0f * (float)(k1 * t2)) / (float)T; F.TW[2 * i] = cospif(a); F.TW[2 * i + 1] = sinpif(a); }
    for (int i = gid; i < 128 * 128; i += NT) { const int mrow = i >> 7, kk = i & 127, p = mrow >> 6, k2 = mrow & 63, pp = kk >> 6, t2 = kk & 63; float v = 0.f;
        if (k2 < 57 && t2 < 57) { const int idx = (k2 * t2) % 57; const float c = cospif((2.0f * (float)idx) / 57.0f), s = sinpif((2.0f * (float)idx) / 57.0f); v = p == pp ? c : (p == 0 ? s : -s); }
        F.A2[i] = (bf16)f2bf(v); }
    const float sc = 1.0f / sqrtf(64.0f * (float)T);
    for (int i = gid; i < 8 * 64 * 128; i += NT) { const int g = i >> 13, n = (i >> 7) & 63, kk = i & 127, seg = kk >> 5, m = kk & 31; const float* wf = F.fw + (size_t)g * 4096 + n; float v;
        if (seg == 0) v = m == 0 ? 0.5f * wf[0] : wf[m * 64];
        else if (seg == 2) v = m == 0 ? 0.5f * wf[0] : wf[(64 - m) * 64];
        else v = m == 0 ? 0.5f * wf[32 * 64] : 0.f;
        F.WF2[i] = (bf16)f2bf(v * sc); }
}
constexpr int P1 = 528, P2 = 1040;
__device__ __forceinline__ void fft1_item(Frame& F, int it) {
    const int hc = it & 1, t2 = (it >> 1) % 57, b = (it >> 1) / 57;
    LAS unsigned char* tile = F.lds + RING_OFF;
    { v4u tmp[9];
#pragma unroll
      for (int i = 0; i < 9; ++i) { const int c = F.tid + 512 * i, t1 = c >> 5, p = (c >> 4) & 1, cc = c & 15, t = 57 * t1 + t2;
        const bf16* src = (t < NMETA ? F.UM + t * NIN : F.U + (size_t)(b * SEQ + t - NMETA) * NIN) + 1024 + 256 * p + 128 * hc + 8 * cc; tmp[i] = *(const v4u*)src; }
#pragma unroll
      for (int i = 0; i < 9; ++i) { const int c = F.tid + 512 * i, t1 = c >> 5, p = (c >> 4) & 1, cc = c & 15; *(LAS v4u*)(tile + t1 * P1 + p * 256 + cc * 16) = tmp[i]; } }
    __syncthreads();
    const int w = F.wave, lane = F.lane, g = lane >> 4, fr = lane & 15, q = fr >> 2, p4 = lane & 3;
    bf16x8 Bf[9];
#pragma unroll
    for (int ks = 0; ks < 9; ++ks) { s16x4 h[2];
#pragma unroll
        for (int t = 0; t < 2; ++t) { const int kk0 = 32 * ks + 8 * g + 4 * t, pl = kk0 >= 144 ? 1 : 0, t1 = kk0 - 144 * pl + q; h[t] = lds_tr(tile + t1 * P1 + pl * 256 + (16 * w + 4 * p4) * 2); }
        Bf[ks] = cat8(h[0], h[1]); }
    __syncthreads();
    f32x4 acc[18];
#pragma unroll
    for (int mt = 0; mt < 18; ++mt) { acc[mt] = (f32x4){0.f, 0.f, 0.f, 0.f}; const bf16* ap = F.A1 + (16 * mt + fr) * 288 + 8 * g;
#pragma unroll
        for (int ks = 0; ks < 9; ++ks) acc[mt] = __builtin_amdgcn_mfma_f32_16x16x32_bf16(*(const bf16x8*)(ap + 32 * ks), Bf[ks], acc[mt], 0, 0, 0);
        if (mt & 1) asm volatile("" ::: "memory"); }
#pragma unroll
    for (int mt = 0; mt < 9; ++mt) { const int k1 = 16 * mt + 4 * g; const f32x4* twp = (const f32x4*)(F.TW + 2 * (t2 * 144 + k1)); const f32x4 ta = twp[0], tb = twp[1];
        const float cs[8] = {ta[0], ta[1], ta[2], ta[3], tb[0], tb[1], tb[2], tb[3]};
#pragma unroll
        for (int r = 0; r < 4; ++r) { const float c = cs[2 * r], s = cs[2 * r + 1], yr = acc[mt][r], yi = acc[mt + 9][r];
            LAS unsigned char* o = tile + (k1 + r) * P1 + (16 * w + fr) * 2;
            *(LAS bf16*)o = (bf16)f2bf(yr * c + yi * s); *(LAS bf16*)(o + 256) = (bf16)f2bf(yi * c - yr * s); } }
    __syncthreads();
#pragma unroll
    for (int i = 0; i < 9; ++i) { const int c = F.tid + 512 * i, k1 = c >> 5, p = (c >> 4) & 1, cc = c & 15;
        *(v4u*)(F.Y + ((size_t)(b * 144 + k1) * 57 + t2) * 512 + 256 * p + 128 * hc + 8 * cc) = *(LAS v4u*)(tile + k1 * P1 + p * 256 + cc * 16); }
    __syncthreads();
}
__device__ __forceinline__ void fft2_item(Frame& F, int it) {
    const int b = it / 144, k1 = it % 144;
    LAS unsigned char* tile = F.lds + RING_OFF;
    const bf16* ysrc = F.Y + (size_t)(b * 144 + k1) * 57 * 512;
    { v4u tmp[8];
#pragma unroll
      for (int i = 0; i < 8; ++i) { const int c = F.tid + 512 * i, t2 = c >> 6, cc = c & 63; tmp[i] = *(const v4u*)(ysrc + (t2 < 57 ? t2 : 56) * 512 + 8 * cc); if (t2 >= 57) tmp[i] = (v4u){0u, 0u, 0u, 0u}; }
#pragma unroll
      for (int i = 0; i < 8; ++i) { const int c = F.tid + 512 * i, t2 = c >> 6, cc = c & 63; *(LAS v4u*)(tile + t2 * P2 + cc * 16) = tmp[i]; } }
    __syncthreads();
    const int w = F.wave, lane = F.lane, g = lane >> 4, fr = lane & 15, q = fr >> 2, p4 = lane & 3;
    bf16x8 Bf[2][4];
#pragma unroll
    for (int nt = 0; nt < 2; ++nt)
#pragma unroll
        for (int ks = 0; ks < 4; ++ks) { s16x4 h[2];
#pragma unroll
            for (int t = 0; t < 2; ++t) { const int kk0 = 32 * ks + 8 * g + 4 * t, pl = kk0 >> 6, t2 = (kk0 & 63) + q; h[t] = lds_tr(tile + t2 * P2 + pl * 512 + (32 * w + 16 * nt + 4 * p4) * 2); }
            Bf[nt][ks] = cat8(h[0], h[1]); }
    __syncthreads();
    f32x4 acc[8][2];
#pragma unroll
    for (int mt = 0; mt < 8; ++mt) { acc[mt][0] = (f32x4){0.f, 0.f, 0.f, 0.f}; acc[mt][1] = (f32x4){0.f, 0.f, 0.f, 0.f}; const bf16* ap = F.A2 + (16 * mt + fr) * 128 + 8 * g;
#pragma unroll
        for (int ks = 0; ks < 4; ++ks) { const bf16x8 a = *(const bf16x8*)(ap + 32 * ks);
            acc[mt][0] = __builtin_amdgcn_mfma_f32_16x16x32_bf16(a, Bf[0][ks], acc[mt][0], 0, 0, 0); acc[mt][1] = __builtin_amdgcn_mfma_f32_16x16x32_bf16(a, Bf[1][ks], acc[mt][1], 0, 0, 0); }
        if (mt & 1) asm volatile("" ::: "memory"); }
#pragma unroll
    for (int mt = 0; mt < 8; ++mt) { const int p = mt >> 2, k2b = 16 * (mt & 3) + 4 * g;
#pragma unroll
        for (int r = 0; r < 4; ++r) if (k2b + r < 57) {
#pragma unroll
            for (int nt = 0; nt < 2; ++nt) *(LAS bf16*)(tile + (k2b + r) * P2 + p * 512 + (32 * w + 16 * nt + fr) * 2) = (bf16)f2bf(acc[mt][nt][r]); } }
    __syncthreads();
#pragma unroll
    for (int i = 0; i < 8; ++i) { const int c = F.tid + 512 * i, k2 = c >> 6, cc = c & 63; if (k2 < 57) *(v4u*)(F.GB + ((size_t)b * T + k1 + 144 * k2) * 512 + 8 * cc) = *(LAS v4u*)(tile + k2 * P2 + cc * 16); }
    __syncthreads();
}
__device__ __forceinline__ void ffin_item(Frame& F, int it) {
    const int b = it >> 7, j0 = 64 * (it & 127);
    LAS unsigned char* tile = F.lds + RING_OFF; LAS float* part = (LAS float*)(F.lds + RING_OFF + 68 * 1024); LAS float* rs = part + 512;
    const int w = F.wave, lane = F.lane, fq = lane >> 4, fr = lane & 15;
    bf16x8 Bf[4][4];
#pragma unroll
    for (int nt = 0; nt < 4; ++nt)
#pragma unroll
        for (int ks = 0; ks < 4; ++ks) Bf[nt][ks] = *(const bf16x8*)(F.WF2 + (size_t)((w * 64 + 16 * nt + fr) * 128 + 32 * ks + 8 * fq));
    f32x4 acc[4][4];
#pragma unroll
    for (int mt = 0; mt < 4; ++mt) { const int k = NMETA + j0 + 16 * mt + fr, kp = T - k; const bf16* gk = F.GB + ((size_t)b * T + k) * 512 + 32 * w + 8 * fq; const bf16* gm = F.GB + ((size_t)b * T + kp) * 512 + 32 * w + 8 * fq;
        const bf16x8 a0 = *(const bf16x8*)gk, a1 = *(const bf16x8*)(gk + 256), a2 = *(const bf16x8*)gm, a3 = *(const bf16x8*)(gm + 256);
#pragma unroll
        for (int nt = 0; nt < 4; ++nt) { f32x4 c = {0.f, 0.f, 0.f, 0.f};
            c = __builtin_amdgcn_mfma_f32_16x16x32_bf16(a0, Bf[nt][0], c, 0, 0, 0); c = __builtin_amdgcn_mfma_f32_16x16x32_bf16(a1, Bf[nt][1], c, 0, 0, 0);
            c = __builtin_amdgcn_mfma_f32_16x16x32_bf16(a2, Bf[nt][2], c, 0, 0, 0); c = __builtin_amdgcn_mfma_f32_16x16x32_bf16(a3, Bf[nt][3], c, 0, 0, 0); acc[mt][nt] = c; }
        asm volatile("" ::: "memory"); }
    float bv[4];
#pragma unroll
    for (int nt = 0; nt < 4; ++nt) bv[nt] = F.fb[64 * w + 16 * nt + fr];
#pragma unroll
    for (int mt = 0; mt < 4; ++mt)
#pragma unroll
        for (int r = 0; r < 4; ++r) { float ss = 0.f;
#pragma unroll
            for (int nt = 0; nt < 4; ++nt) { acc[mt][nt][r] += bv[nt]; ss += acc[mt][nt][r] * acc[mt][nt][r]; }
            ss += __shfl_xor(ss, 1); ss += __shfl_xor(ss, 2); ss += __shfl_xor(ss, 4); ss += __shfl_xor(ss, 8);
            if (fr == 0) part[w * 64 + 16 * mt + 4 * fq + r] = ss; }
    __syncthreads();
    if (F.tid < 64) { float s = 0.f;
#pragma unroll
        for (int ww = 0; ww < 8; ++ww) s += part[ww * 64 + F.tid];
        rs[F.tid] = 1.0f / sqrtf(s * (1.0f / LW) + EPS); }
    __syncthreads();
#pragma unroll
    for (int mt = 0; mt < 4; ++mt)
#pragma unroll
        for (int r = 0; r < 4; ++r) { const int row = 16 * mt + 4 * fq + r; const float rr = rs[row];
#pragma unroll
            for (int nt = 0; nt < 4; ++nt) *(LAS bf16*)(tile + row * P2 + (64 * w + 16 * nt + fr) * 2) = (bf16)f2bf(acc[mt][nt][r] * rr); }
    __syncthreads();
#pragma unroll
    for (int i = 0; i < 8; ++i) { const int c = F.tid + 512 * i, row = c >> 6, cc = c & 63; *(v4u*)(F.YB + (size_t)(b * SEQ + j0 + row) * D + 512 + 8 * cc) = *(LAS v4u*)(tile + row * P2 + cc * 16); }
    __syncthreads();
}


__device__ __forceinline__ float lru_x_at(const bf16* U, const bf16* UM, int b, int t, int C) {
    const int tc = t < 0 ? 0 : (t >= T ? T - 1 : t);
    const bf16* p = tc < NMETA ? UM + tc * NIN + C : U + (size_t)(b * SEQ + tc - NMETA) * NIN + C;
    const float v = bf2f(*p);
    return (t < 0 || t >= T) ? 0.f : v;
}
constexpr int NCH = 257, SCAN_WAVE_BYTES = 17408, SCAN_PART_OFF = 8 * SCAN_WAVE_BYTES;
__device__ __forceinline__ float sigmoid_fast(float x) { return __builtin_amdgcn_rcpf(1.0f + __builtin_amdgcn_exp2f(x * -1.44269504089f)); }
__device__ __forceinline__ float em1_poly(float x) { return x * (1.0f + x * (0.5f + x * ((1.0f / 6.0f) + x * ((1.0f / 24.0f) + x * ((1.0f / 120.0f) + x * (1.0f / 720.0f)))))); }
__device__ __forceinline__ void p0_gate_weights(Frame& F) {
    const int gid = (F.vcu * NWAVES + F.wave) * 64 + F.lane, NT = F.G * NWAVES * 64;
    const float* w00 = F.waf; const float* w01 = F.wxf; const float* w10 = F.wab; const float* w11 = F.wxb;
    for (int i = gid; i < 8 * 64 * 64; i += NT) { const int k = i & 63, n = (i >> 6) & 63, h = i >> 12; const int s = (h * 64 + k) * 64 + n, d = h * 16384 + n * 64 + k;
        F.WG[d] = (bf16)f2bf(w00[s]); F.WG[d + 4096] = (bf16)f2bf(w01[s]); F.WG[d + 8192] = (bf16)f2bf(w10[s]); F.WG[d + 12288] = (bf16)f2bf(w11[s]); }
}
template <int PASS, int DIR, int MT> __device__ __forceinline__ void scan_mt(Frame& F, int b, int t0, int C, int lane, int fr, int fq, LAS float* xcf, LAS float* pre, const bf16x8 (&Bf)[2][4][2],
                                                                          float ba, float bx, float c8, float (&hy)[32], float& hst, float& pp) {
    bf16x8 a[2];
#pragma unroll
    for (int ks = 0; ks < 2; ++ks) { const LAS f32x4* p = (const LAS f32x4*)(xcf + (16 * MT + fr) * 68 + 32 * ks + 8 * fq); const f32x4 u = p[0], v = p[1];
        v4u w; w.x = pg8::cvt_pk_bf16(u[0], u[1]); w.y = pg8::cvt_pk_bf16(u[2], u[3]); w.z = pg8::cvt_pk_bf16(v[0], v[1]); w.w = pg8::cvt_pk_bf16(v[2], v[3]); a[ks] = __builtin_bit_cast(bf16x8, w); }
#pragma unroll
    for (int wh = 0; wh < 2; ++wh)
#pragma unroll
        for (int nt = 0; nt < 4; ++nt) { f32x4 acc = {0.f, 0.f, 0.f, 0.f};
            acc = __builtin_amdgcn_mfma_f32_16x16x32_bf16(a[0], Bf[wh][nt][0], acc, 0, 0, 0); acc = __builtin_amdgcn_mfma_f32_16x16x32_bf16(a[1], Bf[wh][nt][1], acc, 0, 0, 0);
#pragma unroll
            for (int r = 0; r < 4; ++r) pre[(wh * 16 + 4 * fq + r) * 68 + 16 * nt + fr] = acc[r]; }
    LDS_WAIT(); asm volatile("" ::: "memory");
    float gt[16];
    if (PASS == 2 && DIR == 1) {
#pragma unroll
        for (int i = 0; i < 16; ++i) gt[i] = bf2f(F.U[(size_t)(b * SEQ + t0 - NMETA + 16 * MT + i) * NIN + 512 + C]); }
#pragma unroll
    for (int ii = 0; ii < 16; ++ii) { const int i = DIR ? 15 - ii : ii; const int row = 16 * MT + i;
        const float rp = pre[i * 68 + lane] + ba, ip = pre[(16 + i) * 68 + lane] + bx, xcr = xcf[row * 68 + lane];
        const float r = sigmoid_fast(rp), ig = sigmoid_fast(ip), la = c8 * r, la2 = la + la;
        const float av = __builtin_amdgcn_exp2f(la * 1.44269504089f);
        const float m2 = la2 > -0.3f ? -em1_poly(la2) : 1.0f - av * av;
        hst = av * hst + __builtin_amdgcn_sqrtf(m2) * (ig * xcr); pp *= av;
        if (PASS == 2) { if (DIR == 0) hy[row] = hst; else { const float g = gt[i]; const float z = 1.5957691216057308f * (g + 0.044715f * g * g * g); hy[row] = (hy[row] + hst) * g * sigmoid_fast(z); } }
        if ((ii & 3) == 3) asm volatile("" ::: "memory"); }
    LDS_WAIT(); asm volatile("" ::: "memory");
}
template <int PASS, int DIR> __device__ __forceinline__ void scan_dir(Frame& F, int b, int c, int t0, bool ismeta, int h, int C, int lane, int fr, int fq, LAS float* xcf, LAS float* pre, float (&hy)[32]) {
    const float* lamp = DIR ? F.lamb : F.lamf; const float ba = (DIR ? F.bab : F.baf)[C], bx = (DIR ? F.bxb : F.bxf)[C];
    const float c8 = -8.0f * log1pf(expf(-lamp[C]));
    bf16x8 Bf[2][4][2];
#pragma unroll
    for (int wh = 0; wh < 2; ++wh)
#pragma unroll
        for (int nt = 0; nt < 4; ++nt)
#pragma unroll
            for (int ks = 0; ks < 2; ++ks) Bf[wh][nt][ks] = *(const bf16x8*)(F.WG + (size_t)((((h * 2 + DIR) * 2 + wh) * 64 + 16 * nt + fr) * 64 + 32 * ks + 8 * fq));
    float hst = 0.f, pp = 1.0f;
    if (PASS == 2) hst = F.CAR[(size_t)((b * 2 + DIR) * NCH + c) * LW + C];
    if (DIR == 0) { scan_mt<PASS, 0, 0>(F, b, t0, C, lane, fr, fq, xcf, pre, Bf, ba, bx, c8, hy, hst, pp); if (!ismeta) scan_mt<PASS, 0, 1>(F, b, t0, C, lane, fr, fq, xcf, pre, Bf, ba, bx, c8, hy, hst, pp); }
    else          { if (!ismeta) scan_mt<PASS, 1, 1>(F, b, t0, C, lane, fr, fq, xcf, pre, Bf, ba, bx, c8, hy, hst, pp); scan_mt<PASS, 1, 0>(F, b, t0, C, lane, fr, fq, xcf, pre, Bf, ba, bx, c8, hy, hst, pp); }
    if (PASS == 1) { typedef float f32x2v __attribute__((ext_vector_type(2))); *(f32x2v*)(F.SUM + ((size_t)((b * 2 + DIR) * NCH + c) * LW + C) * 2) = (f32x2v){pp, hst}; }
}
template <int PASS> __device__ __forceinline__ void scan_item(Frame& F, int b, int c) {
    int opq = 0; asm volatile("" : "+v"(opq));
    const int h = F.wave, lane = F.lane + opq, C = 64 * h + lane, fr = lane & 15, fq = lane >> 4;
    LAS float* xcf = (LAS float*)(F.lds + RING_OFF + h * SCAN_WAVE_BYTES);
    LAS float* pre = xcf + 32 * 68;
    const bool ismeta = (c == 0); const int t0 = ismeta ? 0 : NMETA + 32 * (c - 1);
    { float x[35];
#pragma unroll
      for (int i = 0; i < 35; ++i) x[i] = lru_x_at(F.U, F.UM, b, t0 - 2 + i, C);
      const float cw0 = F.convw[C], cw1 = F.convw[LW + C], cw2 = F.convw[2 * LW + C], cw3 = F.convw[3 * LW + C], cb = F.convb[C];
#pragma unroll
      for (int r = 0; r < 32; ++r) xcf[r * 68 + lane] = cb + cw0 * x[r] + cw1 * x[r + 1] + cw2 * x[r + 2] + cw3 * x[r + 3]; }
    LDS_WAIT(); asm volatile("" ::: "memory");
    float hy[32];
    scan_dir<PASS, 0>(F, b, c, t0, ismeta, h, C, lane, fr, fq, xcf, pre, hy);
    asm volatile("" ::: "memory");
    if (PASS == 2 || !ismeta) scan_dir<PASS, 1>(F, b, c, t0, ismeta, h, C, lane, fr, fq, xcf, pre, hy);
    if (PASS == 2) {
        LAS float* sq = pre;
        LAS float* part = (LAS float*)(F.lds + RING_OFF + SCAN_PART_OFF); LAS float* rs = part + 256;
#pragma unroll
        for (int r = 0; r < 32; ++r) sq[r * 65 + lane] = hy[r] * hy[r];
        LDS_WAIT(); asm volatile("" ::: "memory");
        { const int rr = lane & 31, hh = lane >> 5; float s = 0.f;
#pragma unroll
          for (int j = 0; j < 32; ++j) s += sq[rr * 65 + 32 * hh + j];
          s += __shfl_xor(s, 32); if (lane < 32) part[h * 32 + lane] = s; }
        __syncthreads();
        if (F.tid < 32) { float s = 0.f;
#pragma unroll
            for (int w = 0; w < 8; ++w) s += part[w * 32 + F.tid];
            rs[F.tid] = 1.0f / sqrtf(s * (1.0f / LW) + EPS); }
        __syncthreads();
        bf16* dst = F.YB + (size_t)(b * SEQ + t0 - NMETA) * D + C;
#pragma unroll
        for (int r = 0; r < 32; ++r) dst[(size_t)r * D] = (bf16)f2bf(hy[r] * rs[r]);
        __syncthreads();
    }
}
__device__ __forceinline__ void carry_scan_block(Frame& F, int blk) {
    typedef float f32x2v __attribute__((ext_vector_type(2)));
    const int h = blk & 7, dir = (blk >> 3) & 1, b = blk >> 4, w = F.wave, lane = F.lane, C = 64 * h + lane;
    LAS f32x2v* comp = (LAS f32x2v*)(F.lds + RING_OFF);
    const size_t base = (size_t)((b * 2 + dir) * NCH) * LW + C;
    f32x2v ps[33];
#pragma unroll
    for (int j = 0; j < 33; ++j) { const int o = 33 * w + j; ps[j] = (f32x2v){1.0f, 0.0f}; if (o < NCH) { const int c = dir ? NCH - 1 - o : o; ps[j] = *(const f32x2v*)(F.SUM + (base + (size_t)c * LW) * 2); } }
    float P = 1.0f, S = 0.0f;
#pragma unroll
    for (int j = 0; j < 33; ++j) { S = ps[j].x * S + ps[j].y; P *= ps[j].x; }
    comp[w * 64 + lane] = (f32x2v){P, S};
    __syncthreads();
    float cin = 0.0f;
    for (int ww = 0; ww < w; ++ww) { const f32x2v q = comp[ww * 64 + lane]; cin = q.x * cin + q.y; }
#pragma unroll
    for (int j = 0; j < 33; ++j) { const int o = 33 * w + j; if (o < NCH) { const int c = dir ? NCH - 1 - o : o; F.CAR[base + (size_t)c * LW] = cin; cin = ps[j].x * cin + ps[j].y; } }
    __syncthreads();
}

__device__ __forceinline__ float gelu_tanh(float x) {
    const float z = 1.5957691216057308f * (x + 0.044715f * x * x * x);
    return x / (1.0f + expf(-z));
}
__device__ __forceinline__ void final_norm(Frame& F) {
    const int gw = F.vcu * NWAVES + F.wave, NGW = F.G * NWAVES, lane = F.lane;
    for (int row = gw; row < M; row += NGW) {
        const float rstd = pg8::row_rstd(F.SL3, row);
        GAS f32x4* p = (GAS f32x4*)(F.out + (size_t)row * D) + lane; const GAS f32x4* gp = (const GAS f32x4*)F.gfin + lane;
#pragma unroll
        for (int j = 0; j < 4; ++j) { const f32x4 v = p[64 * j], g = gp[64 * j]; p[64 * j] = v * rstd * g; }
    }
}

struct Args { const float* in[28]; float* out; unsigned char* ws; int ph_lo, ph_hi, li, pad; };
__global__ void __launch_bounds__(NWAVES * 64, 2) fwd_kernel(Args args) {
    extern __shared__ __attribute__((aligned(16))) unsigned char lds[];
    Frame F;
    F.lds = (LAS unsigned char*)lds;
    F.MISC = (volatile LAS unsigned*)(F.lds + MISC_OFF);
    F.tid = threadIdx.x; F.lane = F.tid & 63; F.wave = __builtin_amdgcn_readfirstlane(F.tid >> 6);
    F.G = gridDim.x; F.bx = blockIdx.x; { const int bx = blockIdx.x; F.vcu = (F.G % 8 == 0) ? (bx % 8) * (F.G / 8) + bx / 8 : bx; }
#define GRID_BAR() do { if (N_LAUNCHES == 1) xcd_barrier(bar); } while (0)
    unsigned char* ws = args.ws;
    F.ctl = (gu32*)(ws + WS_CTL);
    F.x = args.in[0]; F.meta = args.in[1]; F.g1 = args.in[2]; F.w1a = args.in[3]; F.w1b = args.in[4]; F.gmix = args.in[5]; F.win = args.in[6]; F.convw = args.in[7]; F.convb = args.in[8];
    F.waf = args.in[9]; F.baf = args.in[10]; F.wxf = args.in[11]; F.bxf = args.in[12]; F.lamf = args.in[13]; F.wab = args.in[14]; F.bab = args.in[15]; F.wxb = args.in[16]; F.bxb = args.in[17]; F.lamb = args.in[18];
    F.fw = args.in[19]; F.fb = args.in[20]; F.glru = args.in[21]; F.gfour = args.in[22]; F.wout = args.in[23]; F.g2 = args.in[24]; F.w2a = args.in[25]; F.w2b = args.in[26]; F.gfin = args.in[27]; F.out = args.out;
    F.W1A = (bf16*)(ws + WS_W1A); F.W1B = (bf16*)(ws + WS_W1B); F.WIN = (bf16*)(ws + WS_WIN); F.WOUT = (bf16*)(ws + WS_WOUT); F.W2A = (bf16*)(ws + WS_W2A); F.W2B = (bf16*)(ws + WS_W2B);
    F.XN = (bf16*)(ws + WS_XN); F.HB = (bf16*)(ws + WS_HB); F.H1B = (bf16*)(ws + WS_H1B); F.U = (bf16*)(ws + WS_U); F.YB = (bf16*)(ws + WS_YB); F.H2B = (bf16*)(ws + WS_H1B);
    F.XNM = (bf16*)(ws + WS_XNM); F.HBM = (bf16*)(ws + WS_HBM); F.UM = (bf16*)(ws + WS_UM); F.H1ACC = (float*)(ws + WS_H1ACC);
    F.SL1 = (float*)(ws + WS_SL1); F.SL2 = (float*)(ws + WS_SL2); F.SL3 = (float*)(ws + WS_SL3);
    F.A1 = (bf16*)(ws + WS_A1); F.A2 = (bf16*)(ws + WS_A2); F.WF2 = (bf16*)(ws + WS_WF2); F.TW = (float*)(ws + WS_TW); F.Y = (bf16*)(ws + WS_Y); F.GB = (bf16*)(ws + WS_G);
    F.WG = (bf16*)(ws + WS_WG); F.SUM = (float*)(ws + WS_SUM); F.CAR = (float*)(ws + WS_CAR);
    for (int u = F.tid; u < (LDS_BYTES - LDSCTL_OFF) / 4; u += NWAVES * 64) ((LAS unsigned*)(F.lds + LDSCTL_OFF))[u] = 0u;
    __syncthreads();
    XcdBarrier bar; bar.bar = (unsigned*)(F.ctl + CW_BAR); bar.x = 0; bar.st = nullptr;
    if (N_LAUNCHES == 1) bar = xcd_barrier_post((unsigned*)(F.ctl + CW_BAR), F.MISC + 8);
    const int lo = args.ph_lo, hi = args.ph_hi;
#define IN(k) (lo <= (k) && (k) < hi)
    const int slack = ((int)blockIdx.x - 128) * NWAVES + F.wave;

    if (IN(0)) { p0_prologue(F); p0_tables(F); p0_gate_weights(F); GRID_BAR(); }
    if (IN(1)) {
        if (slack >= 0 && slack < FF / 16) meta_stage1(F, slack);
        pg8::Gemm g{F.XN, F.W1A, M, 2 * FF, D}; pg8::StaticOrder S; S.init(M, 2 * FF, F.G, (int)blockIdx.x);
        pg8::EpiSwiglu E{F.HB, FF, nullptr};
        pg8::gemm_phase<pg8::EpiSwiglu, pg8::StaticOrder, PG8_ALIGN, PG8_SP2>(F.lds + RING_OFF, g, S, E);
        GRID_BAR();
    }
    if (IN(2)) {
        { const int piece = (int)blockIdx.x * NWAVES + F.wave; if (piece < 64 * (FF / 128)) meta_stage2(F, piece); }
        pg8::Gemm g{F.HB, F.W1B, M, D, FF}; pg8::StaticOrder S; S.init(M, D, F.G, (int)blockIdx.x);
        pg8::EpiResid E{F.x, F.out, F.H1B, F.SL1, 0.5f, D};
        pg8::gemm_phase<pg8::EpiResid, pg8::StaticOrder, false, PG8_SP2>(F.lds + RING_OFF, g, S, E);
        GRID_BAR();
    }
    if (IN(3)) {
        if (slack >= 0 && slack < NIN / 16) meta_stage3(F, slack);
        pg8::Gemm g{F.H1B, F.WIN, M, NIN, D}; pg8::StaticOrder S; S.init(M, NIN, F.G, (int)blockIdx.x);
        pg8::EpiScaleBf16 E{F.U, NIN, F.SL1};
        pg8::gemm_phase<pg8::EpiScaleBf16, pg8::StaticOrder, PG8_ALIGN, PG8_SP2>(F.lds + RING_OFF, g, S, E);
        GRID_BAR();
    }
    if (IN(4)) {
        for (int it = (int)blockIdx.x; it < 2 * NCH; it += F.G) scan_item<1>(F, it / NCH, it % NCH);
        __syncthreads();
        for (int it = (int)blockIdx.x; it < 2 * 57 * 2; it += F.G) fft1_item(F, it);
        GRID_BAR();
    }
    if (IN(5)) {
        if (blockIdx.x >= F.G - 32) carry_scan_block(F, (int)blockIdx.x - (F.G - 32));
        for (int it = (int)blockIdx.x; it < 2 * 144; it += F.G) fft2_item(F, it);
        GRID_BAR();
    }
    if (IN(6)) {
        for (int it = (int)blockIdx.x; it < 2 * (NCH - 1); it += F.G) scan_item<2>(F, it / (NCH - 1), 1 + it % (NCH - 1));
        for (int it = (int)blockIdx.x; it < 256; it += F.G) ffin_item(F, it);
        GRID_BAR();
    }
    if (IN(7)) {
        pg8::Gemm g{F.YB, F.WOUT, M, D, D}; pg8::StaticOrder S; S.init(M, D, F.G, (int)blockIdx.x);
        pg8::EpiResid E{F.out, F.out, F.H2B, F.SL2, 1.0f, D};
        pg8::gemm_phase<pg8::EpiResid, pg8::StaticOrder, false, PG8_SP2>(F.lds + RING_OFF, g, S, E);
        GRID_BAR();
    }
    if (IN(8)) {
        pg8::Gemm g{F.H2B, F.W2A, M, 2 * FF, D}; pg8::StaticOrder S; S.init(M, 2 * FF, F.G, (int)blockIdx.x);
        pg8::EpiSwiglu E{F.HB, FF, F.SL2};
        pg8::gemm_phase<pg8::EpiSwiglu, pg8::StaticOrder, PG8_ALIGN, PG8_SP2>(F.lds + RING_OFF, g, S, E);
        GRID_BAR();
    }
    if (IN(9)) {
        pg8::Gemm g{F.HB, F.W2B, M, D, FF}; pg8::StaticOrder S; S.init(M, D, F.G, (int)blockIdx.x);
        pg8::EpiResid E{F.out, F.out, nullptr, F.SL3, 0.5f, D};
        pg8::gemm_phase<pg8::EpiResid, pg8::StaticOrder, false, PG8_SP2>(F.lds + RING_OFF, g, S, E);
        GRID_BAR();
    }
    if (IN(10)) { final_norm(F); }
#undef IN
}

extern "C" void kernel_launch(void* const* d_in, const int* in_sizes, int n_in, void* d_out, int out_size, void* d_ws, size_t ws_size, hipStream_t stream) {
    static int grid = 0;
    if (grid == 0) {
        if (n_in != 28 || out_size != M * D || ws_size < WS_END) { fprintf(stderr, "kernel_launch: unexpected shapes: n_in %d out %d ws %zu\n", n_in, out_size, ws_size); grid = -1; return; }
        int dev = 0, cus = 0;
        if (hipGetDevice(&dev) != hipSuccess || hipDeviceGetAttribute(&cus, hipDeviceAttributeMultiprocessorCount, dev) != hipSuccess) { grid = -1; return; }
        if (hipFuncSetAttribute((const void*)fwd_kernel, hipFuncAttributeMaxDynamicSharedMemorySize, LDS_BYTES) != hipSuccess) { fprintf(stderr, "kernel_launch: hipFuncSetAttribute failed\n"); grid = -1; return; }
        int per_cu = 0;
        if (hipOccupancyMaxActiveBlocksPerMultiprocessor(&per_cu, (const void*)fwd_kernel, NWAVES * 64, LDS_BYTES) != hipSuccess || per_cu < 1) fprintf(stderr, "kernel_launch: occupancy query reports %d\n", per_cu);
        (void)hipGetLastError();
        grid = cus;
        if (grid != 256) fprintf(stderr, "kernel_launch: %d CUs (built for 256)\n", grid);
    }
    if (grid < 0) return;
    if (hipMemsetAsync((char*)d_ws + WS_CTL, 0, CTL_ZERO_BYTES, stream) != hipSuccess) return;
    Args a{};
    for (int i = 0; i < 28; ++i) a.in[i] = (const float*)d_in[i];
    a.out = (float*)d_out; a.ws = (unsigned char*)d_ws;
    if (N_LAUNCHES == 1) { a.ph_lo = 0; a.ph_hi = NPH; a.li = 0; hipLaunchKernelGGL(fwd_kernel, dim3(grid), dim3(NWAVES * 64), LDS_BYTES, stream, a); }
    else for (int li = 0; li < NPH; ++li) { a.ph_lo = li; a.ph_hi = li + 1; a.li = li; hipLaunchKernelGGL(fwd_kernel, dim3(grid), dim3(NWAVES * 64), LDS_BYTES, stream, a); }
}
```
